# Optimizing an MI355X kernel written in HIP

```python
import math
import jax, jax.numpy as jnp
from jax import lax
import numpy as np

D_MODEL = 2048
BATCH = 4
SEQ = 8192
DEPTH = 1

HEAD_DIM = 128
FOX_HEADS = D_MODEL // (2 * HEAD_DIM)
GDN_HEADS = D_MODEL // (2 * HEAD_DIM)
FOX_W = FOX_HEADS * HEAD_DIM
GDN_W = GDN_HEADS * HEAD_DIM
MIX_W = FOX_W + GDN_W
CONV_W = 4
GDN_CHUNK = 64
Q_BLOCK = 128
D_FF = 256 * ((8 * D_MODEL // 3 + 255) // 256)
N_MOD = 9
MACARON_W = 0.5
EPS = 1e-6

_SIZES = [FOX_W, FOX_W, FOX_W, FOX_HEADS,
          3 * GDN_W, GDN_HEADS, GDN_HEADS, GDN_W]
IN_W = sum(_SIZES)
SPLIT_IDX = tuple(int(v) for v in np.cumsum(_SIZES)[:-1])

kernel_name = "hybrid_fox_gdn_macaron_adaln"


def rmsnorm(x, g):
    xf = x.astype(jnp.float32)
    y = xf * lax.rsqrt(jnp.mean(xf * xf, axis=-1, keepdims=True) + EPS)
    return y * g.astype(jnp.float32)


def ada_in(x, g, shift, scale):
    y = rmsnorm(x, g) * (1.0 + scale[:, None, :].astype(jnp.float32)) + shift[:, None, :].astype(jnp.float32)
    return y.astype(x.dtype)


def swiglu(h, wg, wu, wd):
    return (jax.nn.silu(h @ wg) * (h @ wu)) @ wd


def l2norm(t):
    return t * lax.rsqrt(jnp.sum(t * t, axis=-1, keepdims=True) + EPS)


def causal_dwconv(x, w):
    k = w.shape[0]
    return lax.conv_general_dilated(
        x, w[:, None, :].astype(x.dtype), window_strides=(1,), padding=[(k - 1, 0)],
        dimension_numbers=("NWC", "WIO", "NWC"), feature_group_count=x.shape[-1])


def forgetting_attention(q, k, v, logf):
    b, h, s, d = q.shape
    nb = s // Q_BLOCK
    scale = 1.0 / math.sqrt(d)
    cum = jnp.cumsum(logf, axis=-1)
    qb = jnp.moveaxis(q.reshape(b, h, nb, Q_BLOCK, d), 2, 0)
    cb = jnp.moveaxis(cum.reshape(b, h, nb, Q_BLOCK), 2, 0)
    kpos = jnp.arange(s)

    def one_block(args):
        i, q_i, c_i = args
        logits = jnp.einsum("bhqd,bhkd->bhqk", q_i, k) * scale + c_i[..., None] - cum[:, :, None, :]
        qpos = i * Q_BLOCK + jnp.arange(Q_BLOCK)
        mask = kpos[None, :] <= qpos[:, None]
        p = jax.nn.softmax(jnp.where(mask, logits, -jnp.inf), axis=-1)
        return jnp.einsum("bhqk,bhkd->bhqd", p, v)

    o = lax.map(one_block, (jnp.arange(nb), qb, cb))
    return jnp.moveaxis(o, 0, 2).reshape(b, h, s, d)


def gated_delta_rule(q, k, v, g, beta):
    b, h, s, dk = q.shape
    dv = v.shape[-1]
    c = GDN_CHUNK
    n = s // c
    q = q * (dk ** -0.5)
    kb = k * beta[..., None]
    vb = v * beta[..., None]
    resh = lambda t: t.reshape(b, h, n, c, *t.shape[3:])
    q, k, kb, vb, g = resh(q), resh(k), resh(kb), resh(vb), resh(g)
    g = jnp.cumsum(g, axis=-1)
    incl = jnp.tril(jnp.ones((c, c), dtype=bool))
    strict = jnp.tril(jnp.ones((c, c), dtype=bool), -1)
    decay = jnp.exp(jnp.where(incl, g[..., :, None] - g[..., None, :], -jnp.inf))
    lower = jnp.where(strict, jnp.einsum("bhnid,bhnjd->bhnij", kb, k) * decay, 0.0)
    eye = jnp.eye(c, dtype=q.dtype)
    t_inv = lax.linalg.triangular_solve(eye + lower, jnp.broadcast_to(eye, lower.shape),
                                        left_side=True, lower=True, unit_diagonal=True)
    u = t_inv @ vb
    w = t_inv @ (kb * jnp.exp(g)[..., None])
    a_intra = jnp.where(incl, jnp.einsum("bhnid,bhnjd->bhnij", q, k) * decay, 0.0)

    def step(state, inp):
        q_i, k_i, u_i, w_i, g_i, a_i = inp
        v_new = u_i - w_i @ state
        o = (q_i * jnp.exp(g_i)[..., None]) @ state + a_i @ v_new
        g_last = g_i[..., -1]
        state = state * jnp.exp(g_last)[..., None, None] + jnp.einsum(
            "bhcd,bhce->bhde", k_i * jnp.exp(g_last[..., None] - g_i)[..., None], v_new)
        return state, o

    mv = lambda t: jnp.moveaxis(t, 2, 0)
    state0 = jnp.zeros((b, h, dk, dv), dtype=q.dtype)
    _, o = lax.scan(step, state0, (mv(q), mv(k), mv(u), mv(w), mv(g), mv(a_intra)))
    return jnp.moveaxis(o, 0, 2).reshape(b, h, s, dv)


def hybrid_mixer(h, w_in, w_out, fox_f_bias, fox_out_norm, gdn_conv, gdn_A_log, gdn_dt_bias, gdn_out_norm):
    bsz, s, _ = h.shape
    proj = (h @ w_in).astype(jnp.float32)
    q_f, k_f, v_f, f_f, qkv_g, a_g, b_g, z_g = jnp.split(proj, SPLIT_IDX, axis=-1)
    heads = lambda t, nh: t.reshape(bsz, s, nh, HEAD_DIM).transpose(0, 2, 1, 3)

    logf = jax.nn.log_sigmoid(f_f + fox_f_bias.astype(jnp.float32)).transpose(0, 2, 1)
    o_f = forgetting_attention(heads(q_f, FOX_HEADS), heads(k_f, FOX_HEADS), heads(v_f, FOX_HEADS), logf)
    o_f = rmsnorm(o_f.transpose(0, 2, 1, 3), fox_out_norm).reshape(bsz, s, FOX_W)

    qkv_g = jax.nn.silu(causal_dwconv(qkv_g, gdn_conv.astype(jnp.float32)))
    q_g, k_g, v_g = jnp.split(qkv_g, 3, axis=-1)
    q_g = l2norm(heads(q_g, GDN_HEADS))
    k_g = l2norm(heads(k_g, GDN_HEADS))
    v_g = heads(v_g, GDN_HEADS)
    g_log = (-jnp.exp(gdn_A_log.astype(jnp.float32))
             * jax.nn.softplus(a_g + gdn_dt_bias.astype(jnp.float32))).transpose(0, 2, 1)
    beta = jax.nn.sigmoid(b_g).transpose(0, 2, 1)
    o_g = gated_delta_rule(q_g, k_g, v_g, g_log, beta).transpose(0, 2, 1, 3)
    z = z_g.reshape(bsz, s, GDN_HEADS, HEAD_DIM)
    o_g = (rmsnorm(o_g, gdn_out_norm) * jax.nn.silu(z)).reshape(bsz, s, GDN_W)

    o = jnp.concatenate([o_f, o_g], axis=-1).astype(h.dtype)
    return o @ w_out


def setup_inputs(seed: int = 0) -> dict:
    key = jax.random.key(seed)
    ks = jax.random.split(key, 20)
    nrm = lambda k, shape, s: jax.random.normal(k, shape, jnp.float32) * s
    x = nrm(ks[0], (BATCH, SEQ, D_MODEL), 1.0)
    c = nrm(ks[1], (BATCH, D_MODEL), 1.0)
    ada_w = nrm(ks[2], (DEPTH, D_MODEL, N_MOD * D_MODEL), 0.5 * D_MODEL ** -0.5)
    ada_b = nrm(ks[3], (DEPTH, N_MOD * D_MODEL), 0.1)
    norm_g = 1.0 + nrm(ks[4], (DEPTH, 3, D_MODEL), 0.1)
    ffn_w_gate = nrm(ks[5], (DEPTH, 2, D_MODEL, D_FF), D_MODEL ** -0.5)
    ffn_w_up = nrm(ks[6], (DEPTH, 2, D_MODEL, D_FF), D_MODEL ** -0.5)
    ffn_w_down = nrm(ks[7], (DEPTH, 2, D_FF, D_MODEL), D_FF ** -0.5)
    w_in = nrm(ks[8], (DEPTH, D_MODEL, IN_W), D_MODEL ** -0.5)
    w_out = nrm(ks[9], (DEPTH, MIX_W, D_MODEL), MIX_W ** -0.5)
    fox_f_bias = 3.0 + nrm(ks[10], (DEPTH, FOX_HEADS), 0.5)
    fox_out_norm = 1.0 + nrm(ks[11], (DEPTH, HEAD_DIM), 0.1)
    gdn_conv = nrm(ks[12], (DEPTH, CONV_W, 3 * GDN_W), CONV_W ** -0.5)
    gdn_A_log = jnp.log(jax.random.uniform(ks[13], (DEPTH, GDN_HEADS), jnp.float32, 1.0, 16.0))
    dt = jnp.exp(jax.random.uniform(ks[14], (DEPTH, GDN_HEADS), jnp.float32,
                                    math.log(1e-3), math.log(1e-1)))
    gdn_dt_bias = dt + jnp.log(-jnp.expm1(-dt))
    gdn_out_norm = 1.0 + nrm(ks[15], (DEPTH, HEAD_DIM), 0.1)
    final_norm = 1.0 + nrm(ks[16], (D_MODEL,), 0.1)
    return {"x": x, "c": c, "ada_w": ada_w, "ada_b": ada_b, "norm_g": norm_g,
            "ffn_w_gate": ffn_w_gate, "ffn_w_up": ffn_w_up, "ffn_w_down": ffn_w_down,
            "w_in": w_in, "w_out": w_out, "fox_f_bias": fox_f_bias, "fox_out_norm": fox_out_norm,
            "gdn_conv": gdn_conv, "gdn_A_log": gdn_A_log, "gdn_dt_bias": gdn_dt_bias,
            "gdn_out_norm": gdn_out_norm, "final_norm": final_norm}


def reference(x, c, ada_w, ada_b, norm_g, ffn_w_gate, ffn_w_up, ffn_w_down, w_in, w_out,
              fox_f_bias, fox_out_norm, gdn_conv, gdn_A_log, gdn_dt_bias, gdn_out_norm, final_norm):
    cond = jax.nn.silu(c)
    for l in range(DEPTH):
        mod = cond @ ada_w[l] + ada_b[l]
        sh1, sc1, gt1, sh2, sc2, gt2, sh3, sc3, gt3 = jnp.split(mod, N_MOD, axis=-1)
        h = ada_in(x, norm_g[l, 0], sh1, sc1)
        x = x + MACARON_W * gt1[:, None, :] * swiglu(h, ffn_w_gate[l, 0], ffn_w_up[l, 0], ffn_w_down[l, 0])
        h = ada_in(x, norm_g[l, 1], sh2, sc2)
        x = x + gt2[:, None, :] * hybrid_mixer(h, w_in[l], w_out[l], fox_f_bias[l], fox_out_norm[l],
                                               gdn_conv[l], gdn_A_log[l], gdn_dt_bias[l], gdn_out_norm[l])
        h = ada_in(x, norm_g[l, 2], sh3, sc3)
        x = x + MACARON_W * gt3[:, None, :] * swiglu(h, ffn_w_gate[l, 1], ffn_w_up[l, 1], ffn_w_down[l, 1])
    return rmsnorm(x, final_norm).astype(x.dtype)
```

```cpp
#include <hip/hip_runtime.h>
#include <hip/hip_bf16.h>
#include <hip/hip_cooperative_groups.h>
#include <cstdio>
#include <cstdint>
namespace cg = cooperative_groups;

constexpr int MTOK = 32768, DM = 2048, DFF = 5632, SEQ = 8192, NB = 4, NHD = 8, HD = 128, NMOD = 18432;
constexpr int NPROJ = 7424;
constexpr int NCHUNK = 128, CH = 64, NTASK = NB * NHD * NCHUNK;
constexpr size_t G1_UT = 0, G1_W = 16384, G1_QG = 32768, G1_KDT = 49152, G1_AQ = 65536, G1_BYTES = 73728;
constexpr int LDS_TOTAL = 139264;
__device__ __forceinline__ int opaque_tid() { int t; asm volatile("v_mov_b32 %0, %1" : "=v"(t) : "v"(threadIdx.x)); return t; }
namespace pg8 {
#define PG8_LAS __attribute__((address_space(3)))
typedef unsigned short bf16_t;
typedef short bf16x8 __attribute__((ext_vector_type(8)));
typedef float f32x4 __attribute__((ext_vector_type(4)));
typedef unsigned u32x4 __attribute__((ext_vector_type(4)));
constexpr int BM = 256, BK = 64, HALF = 128, HTB = HALF * BK * 2  , STAGE_BYTES = 8 * HTB, NXCD = 8, WGM = 8;

__host__ __device__ __forceinline__ int lds_byte(int r, int c) { const int st = (r >> 4) * 2 + (c >> 5), rr = r & 15, cc = c & 31, ob = rr * 64 + cc * 2; return st * 1024 + (ob ^ (((ob >> 9) & 1) << 5)); }
__host__ __device__ __forceinline__ void stage_rc(int b, int& R, int& C) { const int st = b / 1024, sb = b % 1024, swz = sb ^ (((sb >> 9) & 1) << 5); R = (st >> 1) * 16 + swz / 64; C = (st & 1) * 32 + (swz % 64) / 2; }
__host__ __device__ __forceinline__ int perm32(int rho) { const int n = rho >> 4, i = rho & 15; return 8 * (i >> 2) + 4 * n + (i & 3); }

struct Unit { int pm, pn; };
struct Gemm { const bf16_t* A; const bf16_t* Bt; int M, N, K; };

struct StaticOrder {
    int nM, nN, nwg, G, c;
    __host__ __device__ void init(int M, int N, int G_, int c_) { nM = M / BM; nN = N / BM; nwg = nM * nN; G = G_; c = c_; }
    __host__ __device__ bool next(int i, Unit& u) const {
        const long L = (long)i * G + c; if (L >= nwg) return false;
        int wgid = (int)L; { const int q = nwg / NXCD, r = nwg % NXCD, xcd = wgid % NXCD, off = wgid / NXCD; wgid = (xcd < r ? xcd * (q + 1) : r * (q + 1) + (xcd - r) * q) + off; }
        const int nig = WGM * nN, gid = wgid / nig, fm = gid * WGM, gsz = (nM - fm) < WGM ? (nM - fm) : WGM;
        u.pm = fm + ((wgid % nig) % gsz); u.pn = (wgid % nig) / gsz; return true;
    }
    __device__ __forceinline__ void a_ready(const Unit&) const {}
    __device__ __forceinline__ void done(const Unit&) const {}
};
template <class Epi, class Sched, bool STAMP = false>
__device__ __forceinline__ void gemm_phase(PG8_LAS unsigned char* lds, const Gemm g, const Sched& S, const Epi& E, unsigned long long* stamps) {
    const int tid = opaque_tid(), wid = __builtin_amdgcn_readfirstlane(tid >> 6), lane = tid & 63, wr = wid >> 2, wc = wid & 3, fr = lane & 15, fq = lane >> 4;
    const int K = g.K, nt = K / BK;
    int ts_lo = 0, ts_hi = 0, nts = 0; const unsigned long long rt_entry = STAMP ? (unsigned long long)wall_clock64() : 0ull;
#define PG8_STAMP() do { if (STAMP && wid == 0 && nts < 64) { const unsigned long long _c = (unsigned long long)clock64(); \
        ts_lo = (lane == nts) ? (int)(unsigned)_c : ts_lo; ts_hi = (lane == nts) ? (int)(unsigned)(_c >> 32) : ts_hi; ++nts; } } while (0)
    PG8_STAMP();
    unsigned voffA[2], voffB[2];
#pragma unroll
    for (int i = 0; i < 2; ++i) { int R, C; stage_rc(tid * 16 + i * 8192, R, C); const int Rb = Epi::PERM ? ((R & ~31) + perm32(R & 31)) : R;
        voffA[i] = (unsigned)(R * K + C) * 2u; voffB[i] = (unsigned)(Rb * K + C) * 2u; }
    const size_t kstep = (size_t)(BK * 2);
    const size_t hstep = (size_t)HALF * K * 2;
    const size_t tstep = 2 * hstep;
    const unsigned ldsw = (unsigned)wid * 1024u;
    const int aoff = lds_byte(wr * 64 + fr, fq * 8), boff = lds_byte(wc * 32 + fr, fq * 8);
#define PG8_SA(b, h) (((b) * 2 + (h)) * HTB)
#define PG8_SB(b, h) ((4 + (b) * 2 + (h)) * HTB)
#define PG8_STAGE(bufoff, gbase, voff) do { _Pragma("unroll") for (int _i = 0; _i < 2; ++_i) \
        __builtin_amdgcn_global_load_lds((const unsigned*)((const char*)(gbase) + (voff)[_i]), (PG8_LAS unsigned*)(lds + (bufoff) + ldsw + _i * 8192), 16, 0, 0); } while (0)
#define PG8_LDA(dst, b, h) do { _Pragma("unroll") for (int m = 0; m < 4; ++m) _Pragma("unroll") for (int k = 0; k < 2; ++k) dst[m][k] = *(const PG8_LAS bf16x8*)(lds + PG8_SA(b, h) + aoff + m * 2048 + k * 1024); } while (0)
#define PG8_LDB(dst, b, h) do { _Pragma("unroll") for (int n = 0; n < 2; ++n) _Pragma("unroll") for (int k = 0; k < 2; ++k) dst[n][k] = *(const PG8_LAS bf16x8*)(lds + PG8_SB(b, h) + boff + n * 2048 + k * 1024); } while (0)
#define PG8_MMA(ai, bj, At, Bt) do { __builtin_amdgcn_s_setprio(1); _Pragma("unroll") for (int m = 0; m < 4; ++m) _Pragma("unroll") for (int n = 0; n < 2; ++n) _Pragma("unroll") for (int k = 0; k < 2; ++k) \
        acc[ai][bj][m][n] = __builtin_amdgcn_mfma_f32_16x16x32_bf16(Bt[n][k], At[m][k], acc[ai][bj][m][n], 0, 0, 0); __builtin_amdgcn_s_setprio(0); } while (0)
#define PG8_WAIT_V(n) asm volatile("s_waitcnt vmcnt(" #n ")" ::: "memory")
#define PG8_WAIT_L(n) asm volatile("s_waitcnt lgkmcnt(" #n ")" ::: "memory")
#define PG8_BAR __builtin_amdgcn_s_barrier()
#define PG8_SCHED __builtin_amdgcn_sched_barrier(0)
    Unit cur, nxt; int ui = 0;
    if (!S.next(0, cur)) return;
    f32x4 acc[2][2][4][2];
#pragma unroll
    for (int a = 0; a < 2; ++a)
#pragma unroll
        for (int b = 0; b < 2; ++b)
#pragma unroll
            for (int m = 0; m < 4; ++m)
#pragma unroll
                for (int n = 0; n < 2; ++n) acc[a][b][m][n] = (f32x4){0.f, 0.f, 0.f, 0.f};
    bf16x8 At[4][2], B0[2][2], B1[2][2];
    const char* cA = (const char*)g.A + (size_t)cur.pm * tstep; const char* cB = (const char*)g.Bt + (size_t)cur.pn * tstep;
    S.a_ready(cur);
    PG8_STAGE(PG8_SB(0, 0), cB, voffB); PG8_STAGE(PG8_SA(0, 0), cA, voffA); PG8_STAGE(PG8_SB(0, 1), cB + hstep, voffB); PG8_STAGE(PG8_SA(0, 1), cA + hstep, voffA);
    if (wr == 1) PG8_BAR;
    PG8_WAIT_V(4); PG8_BAR;
    PG8_STAGE(PG8_SB(1, 0), cB + kstep, voffB); PG8_STAGE(PG8_SA(1, 0), cA + kstep, voffA); PG8_STAGE(PG8_SB(1, 1), cB + hstep + kstep, voffB);
    PG8_WAIT_V(6); PG8_BAR;
    PG8_STAMP();
    for (;;) {
        const bool has_next = S.next(ui + 1, nxt);
        const char* nA = has_next ? (const char*)g.A + (size_t)nxt.pm * tstep : cA; const char* nB = has_next ? (const char*)g.Bt + (size_t)nxt.pn * tstep : cB;
        for (int t = 0; t < nt; t += 2) {
            const bool last = (t == nt - 2);
            const char* a1 = cA + (size_t)(t + 1) * kstep;
            const char* a2 = last ? nA : cA + (size_t)(t + 2) * kstep; const char* b2 = last ? nB : cB + (size_t)(t + 2) * kstep;
            const char* a3 = a2 + kstep; const char* b3 = b2 + kstep;
            if (last && has_next) S.a_ready(nxt);
            PG8_LDB(B0, 0, 0); PG8_SCHED; PG8_LDA(At, 0, 0); PG8_STAGE(PG8_SA(1, 1), a1 + hstep, voffA);
            PG8_WAIT_L(8); PG8_BAR; PG8_WAIT_L(0); PG8_MMA(0, 0, At, B0); PG8_BAR; PG8_SCHED;
            PG8_LDB(B1, 0, 1); PG8_STAGE(PG8_SB(0, 0), b2, voffB);
            PG8_BAR; PG8_WAIT_L(0); PG8_MMA(0, 1, At, B1); PG8_BAR;
            PG8_LDA(At, 0, 1); PG8_STAGE(PG8_SA(0, 0), a2, voffA);
            PG8_BAR; PG8_WAIT_L(0); PG8_MMA(1, 0, At, B0); PG8_BAR; PG8_SCHED;
            PG8_STAGE(PG8_SB(0, 1), b2 + hstep, voffB);
            PG8_WAIT_V(6); PG8_BAR; PG8_MMA(1, 1, At, B1); PG8_BAR;
            PG8_LDB(B0, 1, 0); PG8_SCHED; PG8_LDA(At, 1, 0); PG8_STAGE(PG8_SA(0, 1), a2 + hstep, voffA);
            PG8_WAIT_L(8); PG8_BAR; PG8_WAIT_L(0); PG8_MMA(0, 0, At, B0); PG8_BAR; PG8_SCHED;
            PG8_LDB(B1, 1, 1); PG8_STAGE(PG8_SB(1, 0), b3, voffB);
            PG8_BAR; PG8_WAIT_L(0); PG8_MMA(0, 1, At, B1); PG8_BAR;
            PG8_LDA(At, 1, 1); PG8_STAGE(PG8_SA(1, 0), a3, voffA);
            PG8_BAR; PG8_WAIT_L(0); PG8_MMA(1, 0, At, B0); PG8_BAR; PG8_SCHED;
            PG8_STAGE(PG8_SB(1, 1), b3 + hstep, voffB);
            PG8_WAIT_V(6); PG8_BAR; PG8_MMA(1, 1, At, B1); PG8_BAR;
        }
        PG8_STAMP();
        if constexpr (!Epi::AFTER_DRAIN) { E(acc, cur, wr, wc, fr, fq); S.done(cur); }
        PG8_STAMP();
        if (!has_next) break;
#pragma unroll
        for (int a = 0; a < 2; ++a)
#pragma unroll
            for (int b = 0; b < 2; ++b)
#pragma unroll
                for (int m = 0; m < 4; ++m)
#pragma unroll
                    for (int n = 0; n < 2; ++n) acc[a][b][m][n] = (f32x4){0.f, 0.f, 0.f, 0.f};
        cur = nxt; cA = nA; cB = nB; ++ui;
    }
    PG8_WAIT_V(0);
    if (wr == 0) PG8_BAR;
    PG8_BAR;
    if constexpr (Epi::AFTER_DRAIN) { E.fused(acc, cur, wr, wc, fr, fq, lds, wid, lane); S.done(cur); }
    PG8_STAMP();
    if (STAMP && wid == 0) { stamps[lane] = lane < nts ? (((unsigned long long)(unsigned)ts_hi << 32) | (unsigned)ts_lo) : 0ull;
        if (lane == 62) stamps[62] = rt_entry; if (lane == 63) stamps[63] = (unsigned long long)wall_clock64(); }
#undef PG8_STAMP
#undef PG8_SA
#undef PG8_SB
#undef PG8_STAGE
#undef PG8_LDA
#undef PG8_LDB
#undef PG8_MMA
#undef PG8_WAIT_V
#undef PG8_WAIT_L
#undef PG8_BAR
#undef PG8_SCHED
}
}
using pg8::bf16_t; using pg8::bf16x8; using pg8::f32x4; using pg8::u32x4; using pg8::Unit;
typedef unsigned u32x2 __attribute__((ext_vector_type(2)));

struct Params {
    const float *x, *c, *ada_w, *ada_b, *norm_g, *wg, *wu, *wd, *w_in, *w_out, *fox_f_bias, *fox_out_norm, *gdn_conv, *gdn_A_log, *gdn_dt_bias, *gdn_out_norm, *final_norm;
    float* out;
    bf16_t *WGU, *WD, *WIN, *WOUT, *H, *QKVF, *QKVG, *Z, *HID;
    float *MOD, *SMALL, *BIAS, *GL, *OG;
    unsigned char* G1OUT;
};

__device__ __forceinline__ unsigned cvtpk(float lo, float hi) { unsigned r; asm volatile("v_cvt_pk_bf16_f32 %0, %1, %2" : "=v"(r) : "v"(lo), "v"(hi)); return r; }
__device__ __forceinline__ float bf2f(unsigned short b) { return __uint_as_float(((unsigned)b) << 16); }
__device__ __forceinline__ float bflo(unsigned w) { return __uint_as_float(w << 16); }
__device__ __forceinline__ float bfhi(unsigned w) { return __uint_as_float(w & 0xffff0000u); }
__device__ __forceinline__ float wave_sum(float v) { for (int o = 32; o; o >>= 1) v += __shfl_xor(v, o); return v; }
__device__ __forceinline__ float silu_f(float v) { return v * __builtin_amdgcn_rcpf(1.f + __expf(-v)); }
__device__ __forceinline__ float softplus_f(float v) { return fmaxf(v, 0.f) + log1pf(__expf(-fabsf(v))); }

struct EpiSwiGLU { static constexpr bool PERM = true, AFTER_DRAIN = false; bf16_t* O;
    __device__ __forceinline__ void operator()(const f32x4 (&acc)[2][2][4][2], const Unit& u, int wr, int wc, int fr, int fq) const {
        const int row0 = u.pm * 256 + wr * 64 + fr, col0 = u.pn * 128 + wc * 32 + 8 * fq;
#pragma unroll
        for (int ai = 0; ai < 2; ++ai)
#pragma unroll
            for (int m = 0; m < 4; ++m) { bf16_t* rowp = O + (size_t)(row0 + ai * 128 + m * 16) * DFF + col0;
                float h[8];
#pragma unroll
                for (int n = 0; n < 2; ++n)
#pragma unroll
                    for (int j = 0; j < 4; ++j) h[n * 4 + j] = silu_f(acc[ai][0][m][n][j]) * acc[ai][1][m][n][j];
                *(u32x4*)rowp = (u32x4){cvtpk(h[0], h[1]), cvtpk(h[2], h[3]), cvtpk(h[4], h[5]), cvtpk(h[6], h[7])}; }
    }
};
struct EpiResid { static constexpr bool PERM = false, AFTER_DRAIN = false; const float* xin; float* out; const float* gate; float s;
    __device__ __forceinline__ void operator()(const f32x4 (&acc)[2][2][4][2], const Unit& u, int wr, int wc, int fr, int fq) const {
        const int row0 = u.pm * 256 + wr * 64 + fr, col0 = u.pn * 256 + wc * 32 + 4 * fq, b = u.pm >> 5;
        f32x4 gv[2][2];
#pragma unroll
        for (int bj = 0; bj < 2; ++bj)
#pragma unroll
            for (int n = 0; n < 2; ++n) gv[bj][n] = *(const f32x4*)(gate + (size_t)b * NMOD + col0 + bj * 128 + n * 16) * s;
#pragma unroll
        for (int ai = 0; ai < 2; ++ai)
#pragma unroll
            for (int m = 0; m < 4; ++m) { const size_t ro = (size_t)(row0 + ai * 128 + m * 16) * DM + col0;
#pragma unroll
                for (int bj = 0; bj < 2; ++bj)
#pragma unroll
                    for (int n = 0; n < 2; ++n) { const f32x4 xv = *(const f32x4*)(xin + ro + bj * 128 + n * 16);
                        *(f32x4*)(out + ro + bj * 128 + n * 16) = xv + gv[bj][n] * acc[ai][bj][m][n]; } }
    }
};
struct EpiProj { static constexpr bool PERM = true, AFTER_DRAIN = false; bf16_t *qkvf, *qkvg, *z; float* small;
    __device__ __forceinline__ void operator()(const f32x4 (&acc)[2][2][4][2], const Unit& u, int wr, int wc, int fr, int fq) const {
        const int row0 = u.pm * 256 + wr * 64 + fr;
        if (u.pn == 28) {
            if (wc == 0) {
#pragma unroll
                for (int ai = 0; ai < 2; ++ai)
#pragma unroll
                    for (int m = 0; m < 4; ++m) { float* rp = small + (size_t)(row0 + ai * 128 + m * 16) * 32 + 8 * fq;
                        *(f32x4*)rp = acc[ai][0][m][0]; *(f32x4*)(rp + 4) = acc[ai][0][m][1]; }
            }
            return;
        }
        bf16_t* base; int ld, ct;
        if (u.pn < 12) { base = qkvf; ld = 3072; ct = u.pn; } else if (u.pn < 24) { base = qkvg; ld = 3072; ct = u.pn - 12; } else { base = z; ld = 1024; ct = u.pn - 24; }
        const int col0 = ct * 256 + wc * 32 + 8 * fq;
#pragma unroll
        for (int ai = 0; ai < 2; ++ai)
#pragma unroll
            for (int m = 0; m < 4; ++m) { bf16_t* rowp = base + (size_t)(row0 + ai * 128 + m * 16) * ld + col0;
#pragma unroll
                for (int bj = 0; bj < 2; ++bj) { const f32x4 v0 = acc[ai][bj][m][0], v1 = acc[ai][bj][m][1];
                    *(u32x4*)(rowp + bj * 128) = (u32x4){cvtpk(v0[0], v0[1]), cvtpk(v0[2], v0[3]), cvtpk(v1[0], v1[1]), cvtpk(v1[2], v1[3])}; } }
    }
};
__device__ __forceinline__ void mod_task(const Params& p, int t, const float* cond, float* red) {
    const int tid = opaque_tid(), wv = tid >> 6, lane = tid & 63, col = t * 64 + lane;
    float a0 = 0.f, a1 = 0.f, a2 = 0.f, a3 = 0.f;
    const float* w = p.ada_w + (size_t)(wv * 256) * NMOD + col;
    const float* cd = cond + wv * 256;
#pragma unroll 8
    for (int k = 0; k < 256; ++k) { const float v = w[(size_t)k * NMOD]; a0 += cd[k] * v; a1 += cd[2048 + k] * v; a2 += cd[4096 + k] * v; a3 += cd[6144 + k] * v; }
    red[(wv * 4 + 0) * 64 + lane] = a0; red[(wv * 4 + 1) * 64 + lane] = a1; red[(wv * 4 + 2) * 64 + lane] = a2; red[(wv * 4 + 3) * 64 + lane] = a3;
    __syncthreads();
    if (tid < 256) { const int b = tid >> 6; float s = p.ada_b[col];
#pragma unroll
        for (int w8 = 0; w8 < 8; ++w8) s += red[(w8 * 4 + b) * 64 + lane];
        p.MOD[(size_t)b * NMOD + col] = s; }
    __syncthreads();
}
__device__ __forceinline__ const float* wmap_col(int mode, const float* s0, const float* s1, int r) {
    if (mode == 0) return s0 + r;
    if (mode == 1) { const int pn = r >> 8, bj = (r >> 7) & 1, u = r & 127; return (bj ? s1 : s0) + 128 * pn + u; }
    int c;
    if (r < 3072) c = r; else if (r < 6144) c = 3080 + (r - 3072); else if (r < 7168) c = 6168 + (r - 6144);
    else if (r < 7176) c = 3072 + (r - 7168); else if (r < 7184) c = 6152 + (r - 7176); else if (r < 7192) c = 6160 + (r - 7184); else return nullptr;
    return s0 + c;
}
__device__ __forceinline__ void conv_tile(int mode, const float* s0, const float* s1, int ld, bf16_t* dst, int K, int n0, int k0, float* tile) {
    const int tid = opaque_tid(), n = tid & 63, kq = tid >> 6;
    const float* cp = wmap_col(mode, s0, s1, n0 + n);
    float v[8];
#pragma unroll
    for (int i = 0; i < 8; ++i) v[i] = cp ? cp[(size_t)(k0 + i * 8 + kq) * ld] : 0.f;
#pragma unroll
    for (int i = 0; i < 8; ++i) tile[n * 65 + i * 8 + kq] = v[i];
    __syncthreads();
    const int n2 = tid >> 3, kg = tid & 7; const float* tp = tile + n2 * 65 + kg * 8;
    *(u32x4*)(dst + (size_t)(n0 + n2) * K + k0 + kg * 8) = (u32x4){cvtpk(tp[0], tp[1]), cvtpk(tp[2], tp[3]), cvtpk(tp[4], tp[5]), cvtpk(tp[6], tp[7])};
    __syncthreads();
}
__device__ __forceinline__ void conv_weight(int idx, int mode, const float* s0, const float* s1, int ld, bf16_t* dst, int K, int ntn, float* tile) {
    conv_tile(mode, s0, s1, ld, dst, K, (idx % ntn) * 64, (idx / ntn) * 64, tile);
}
constexpr int CT_GU = 176 * 32, CT_D = 32 * 88, CT_IN = 116 * 32, CT_OUT = 32 * 32;
__device__ __forceinline__ void conv_ffn(const Params& p, int l, int idx, float* tile) {
    if (idx < CT_GU) conv_weight(idx, 1, p.wg + (size_t)l * DM * DFF, p.wu + (size_t)l * DM * DFF, DFF, p.WGU, DM, 176, tile);
    else conv_weight(idx - CT_GU, 0, p.wd + (size_t)l * DFF * DM, nullptr, DM, p.WD, DFF, 32, tile);
}
__device__ __forceinline__ void phase_prologue(const Params& p, unsigned char* lds) {
    float* cond = (float*)lds; float* red = cond + 8192; float* tile = (float*)lds;
    const int tid = opaque_tid();
    if ((int)blockIdx.x < 288) {
        for (int i = tid; i < 8192; i += 512) { const float c = p.c[i]; cond[i] = c / (1.f + __expf(-c)); }
        __syncthreads();
        for (int t = blockIdx.x; t < 288; t += gridDim.x) mod_task(p, t, cond, red);
    }
    constexpr int NT0 = CT_GU + CT_D, NT1 = NT0 + CT_IN, NT2 = NT1 + CT_OUT;
    for (int t = blockIdx.x; t < NT2; t += gridDim.x) {
        if (t < NT0) conv_ffn(p, 0, t, tile);
        else if (t < NT1) conv_weight(t - NT0, 2, p.w_in, nullptr, 7192, p.WIN, DM, 116, tile);
        else conv_weight(t - NT1, 0, p.w_out, nullptr, DM, p.WOUT, DM, 32, tile);
    }
}
__device__ __forceinline__ void phase_norm(const float* xin, const float* g, const float* mod, int shift_idx, int scale_idx, bf16_t* h) {
    const int tid = opaque_tid(), lane = tid & 63, gw = blockIdx.x * 8 + (tid >> 6), GW = gridDim.x * 8;
    for (int row = gw; row < MTOK; row += GW) {
        const int b = row >> 13; const float* xr = xin + (size_t)row * DM;
        f32x4 v[8]; float ss = 0.f;
#pragma unroll
        for (int i = 0; i < 8; ++i) { v[i] = *(const f32x4*)(xr + 4 * (lane + 64 * i)); ss += v[i][0] * v[i][0] + v[i][1] * v[i][1] + v[i][2] * v[i][2] + v[i][3] * v[i][3]; }
        ss = wave_sum(ss); const float r = __builtin_amdgcn_rsqf(ss * (1.f / DM) + 1e-6f);
        const float* sh = mod + (size_t)b * NMOD + shift_idx * DM; const float* sc = mod + (size_t)b * NMOD + scale_idx * DM;
#pragma unroll
        for (int i = 0; i < 8; ++i) { const int col = 4 * (lane + 64 * i);
            const f32x4 gg = *(const f32x4*)(g + col), s1 = *(const f32x4*)(sc + col), s0 = *(const f32x4*)(sh + col);
            const f32x4 y = v[i] * r * gg * (s1 + 1.f) + s0;
            *(u32x2*)(h + (size_t)row * DM + col) = (u32x2){cvtpk(y[0], y[1]), cvtpk(y[2], y[3])}; }
    }
}
__device__ __forceinline__ void phase_final_norm(float* x, const float* g) {
    const int tid = opaque_tid(), lane = tid & 63, gw = blockIdx.x * 8 + (tid >> 6), GW = gridDim.x * 8;
    for (int row = gw; row < MTOK; row += GW) {
        float* xr = x + (size_t)row * DM;
        f32x4 v[8]; float ss = 0.f;
#pragma unroll
        for (int i = 0; i < 8; ++i) { v[i] = *(const f32x4*)(xr + 4 * (lane + 64 * i)); ss += v[i][0] * v[i][0] + v[i][1] * v[i][1] + v[i][2] * v[i][2] + v[i][3] * v[i][3]; }
        ss = wave_sum(ss); const float r = __builtin_amdgcn_rsqf(ss * (1.f / DM) + 1e-6f);
#pragma unroll
        for (int i = 0; i < 8; ++i) { const int col = 4 * (lane + 64 * i); *(f32x4*)(xr + col) = v[i] * r * *(const f32x4*)(g + col); }
    }
}
__device__ __forceinline__ void phase_gdn_out(const Params& p) {
    const int tid = opaque_tid(), lane = tid & 63, half = lane >> 5, l32 = lane & 31, gw = blockIdx.x * 8 + (tid >> 6), GW = gridDim.x * 8;
    const f32x4 gn = *(const f32x4*)(p.gdn_out_norm + 4 * l32);
    for (int it = gw; it < MTOK * NHD / 2; it += GW) {
        const int grp = it * 2 + half, row = grp >> 3, h = grp & 7;
        const f32x4 v = *(const f32x4*)(p.OG + (size_t)row * 1024 + h * 128 + 4 * l32);
        const u32x2 zz = *(const u32x2*)(p.Z + (size_t)row * 1024 + h * 128 + 4 * l32);
        float ss = v[0] * v[0] + v[1] * v[1] + v[2] * v[2] + v[3] * v[3];
        ss += __shfl_xor(ss, 1); ss += __shfl_xor(ss, 2); ss += __shfl_xor(ss, 4); ss += __shfl_xor(ss, 8); ss += __shfl_xor(ss, 16);
        const float r = __builtin_amdgcn_rsqf(ss * (1.f / 128.f) + 1e-6f);
        const float y0 = v[0] * r * gn[0] * silu_f(bflo(zz[0])), y1 = v[1] * r * gn[1] * silu_f(bfhi(zz[0]));
        const float y2 = v[2] * r * gn[2] * silu_f(bflo(zz[1])), y3 = v[3] * r * gn[3] * silu_f(bfhi(zz[1]));
        *(u32x2*)(p.H + (size_t)row * DM + 1024 + h * 128 + 4 * l32) = (u32x2){cvtpk(y0, y1), cvtpk(y2, y3)};
    }
}
__device__ __forceinline__ void cumsum_task(const Params& p, int bh, float* wsum) {
    const int tid = opaque_tid(), wv = tid >> 6, lane = tid & 63, b = bh >> 3, h = bh & 7;
    const float fb = p.fox_f_bias[h];
    float loc[16]; float run = 0.f;
#pragma unroll
    for (int i = 0; i < 16; ++i) { const float xv = p.SMALL[(size_t)(b * SEQ + tid * 16 + i) * 32 + h] + fb; run += fminf(xv, 0.f) - log1pf(__expf(-fabsf(xv))); loc[i] = run; }
    float inc = run;
#pragma unroll
    for (int o = 1; o < 64; o <<= 1) { const float t = __shfl_up(inc, o); if (lane >= o) inc += t; }
    if (lane == 63) wsum[wv] = inc;
    __syncthreads();
    float off = inc - run;
    for (int w8 = 0; w8 < wv; ++w8) off += wsum[w8];
#pragma unroll
    for (int i = 0; i < 16; ++i) p.BIAS[(size_t)bh * SEQ + tid * 16 + i] = -(off + loc[i]) * 11.313708498984761f;
    __syncthreads();
}
constexpr int G1L_QS = 0, G1L_KS = 17408, G1L_KBS = 34816, G1L_RU = 52224, G1L_RW = 84992, G1L_LS = 117760, G1L_GC = 134144, G1L_BETA = 134400;
__device__ __forceinline__ void g1_conv_part(const Params& p, int part, int b, int h, int t0, int tok, int ch0, float (&y)[16]) {
    const int colbase = part * 1024 + h * 128 + ch0;
#pragma unroll
    for (int e = 0; e < 16; ++e) y[e] = 0.f;
#pragma unroll
    for (int kk = 0; kk < 4; ++kk) {
        const int tt = t0 + tok - 3 + kk;
        u32x4 x0 = (u32x4){0u, 0u, 0u, 0u}, x1 = x0;
        if (tt >= 0) { const bf16_t* xp = p.QKVG + (size_t)(b * SEQ + tt) * 3072 + colbase; x0 = *(const u32x4*)xp; x1 = *(const u32x4*)(xp + 8); }
        const float* wp = p.gdn_conv + (size_t)kk * 3072 + colbase;
        const f32x4 w0 = *(const f32x4*)wp, w1 = *(const f32x4*)(wp + 4), w2 = *(const f32x4*)(wp + 8), w3 = *(const f32x4*)(wp + 12);
        y[0] += w0[0] * bflo(x0[0]); y[1] += w0[1] * bfhi(x0[0]); y[2] += w0[2] * bflo(x0[1]); y[3] += w0[3] * bfhi(x0[1]);
        y[4] += w1[0] * bflo(x0[2]); y[5] += w1[1] * bfhi(x0[2]); y[6] += w1[2] * bflo(x0[3]); y[7] += w1[3] * bfhi(x0[3]);
        y[8] += w2[0] * bflo(x1[0]); y[9] += w2[1] * bfhi(x1[0]); y[10] += w2[2] * bflo(x1[1]); y[11] += w2[3] * bfhi(x1[1]);
        y[12] += w3[0] * bflo(x1[2]); y[13] += w3[1] * bfhi(x1[2]); y[14] += w3[2] * bflo(x1[3]); y[15] += w3[3] * bfhi(x1[3]);
    }
#pragma unroll
    for (int e = 0; e < 16; ++e) y[e] = silu_f(y[e]);
}
__device__ __forceinline__ void st16_bf16(unsigned char* dst, const float (&y)[16], float s) {
    *(u32x4*)dst = (u32x4){cvtpk(y[0] * s, y[1] * s), cvtpk(y[2] * s, y[3] * s), cvtpk(y[4] * s, y[5] * s), cvtpk(y[6] * s, y[7] * s)};
    *(u32x4*)(dst + 16) = (u32x4){cvtpk(y[8] * s, y[9] * s), cvtpk(y[10] * s, y[11] * s), cvtpk(y[12] * s, y[13] * s), cvtpk(y[14] * s, y[15] * s)};
}
__device__ __forceinline__ void st16_f32(float* dst, const float (&y)[16], float s) {
#pragma unroll
    for (int q = 0; q < 4; ++q) *(f32x4*)(dst + 4 * q) = (f32x4){y[4 * q] * s, y[4 * q + 1] * s, y[4 * q + 2] * s, y[4 * q + 3] * s};
}
__device__ __forceinline__ void g1_task(const Params& p, int task, unsigned char* lds) {
    const int tid = opaque_tid(), wv = __builtin_amdgcn_readfirstlane(tid >> 6), lane = tid & 63, fr = lane & 15, fq = lane >> 4;
    const int bh = task >> 7, n = task & 127, b = bh >> 3, h = bh & 7, t0 = n * CH;
    float* gcs = (float*)(lds + G1L_GC); float* betas = (float*)(lds + G1L_BETA); float* LS = (float*)(lds + G1L_LS);
    unsigned char* gout = p.G1OUT + (size_t)task * G1_BYTES;
    if (wv == 0) {
        const size_t row = (size_t)(b * SEQ + t0 + lane);
        const float al = p.SMALL[row * 32 + 8 + h], bl = p.SMALL[row * 32 + 16 + h];
        const float g = -__expf(p.gdn_A_log[h]) * softplus_f(al + p.gdn_dt_bias[h]);
        float inc = g;
#pragma unroll
        for (int o = 1; o < 64; o <<= 1) { const float t = __shfl_up(inc, o); if (lane >= o) inc += t; }
        gcs[lane] = inc; betas[lane] = 1.f / (1.f + __expf(-bl));
        if (lane == 63) p.GL[task] = __expf(inc);
    }
    __syncthreads();
    {
        const int tok = tid >> 3, ch0 = (tid & 7) * 16;
        const float gc = gcs[tok], beta = betas[tok], eg = __expf(gc);
        float y[16];
        g1_conv_part(p, 1, b, h, t0, tok, ch0, y);
        { float ss = 0.f;
#pragma unroll
          for (int e = 0; e < 16; ++e) ss += y[e] * y[e];
          ss += __shfl_xor(ss, 1); ss += __shfl_xor(ss, 2); ss += __shfl_xor(ss, 4);
          const float inv = __builtin_amdgcn_rsqf(ss + 1e-6f);
          st16_bf16(lds + G1L_KS + tok * 272 + ch0 * 2, y, inv);
          st16_bf16(lds + G1L_KBS + tok * 272 + ch0 * 2, y, inv * beta);
          st16_f32((float*)(lds + G1L_RW) + tok * 128 + ch0, y, inv * beta * eg); }
        g1_conv_part(p, 0, b, h, t0, tok, ch0, y);
        { float ss = 0.f;
#pragma unroll
          for (int e = 0; e < 16; ++e) ss += y[e] * y[e];
          ss += __shfl_xor(ss, 1); ss += __shfl_xor(ss, 2); ss += __shfl_xor(ss, 4);
          const float inv = __builtin_amdgcn_rsqf(ss + 1e-6f) * 0.08838834764831845f;
          st16_bf16(lds + G1L_QS + tok * 272 + ch0 * 2, y, inv);
          st16_bf16(gout + G1_QG + (tok * 128 + ch0) * 2, y, inv * eg); }
        g1_conv_part(p, 2, b, h, t0, tok, ch0, y);
        st16_f32((float*)(lds + G1L_RU) + tok * 128 + ch0, y, beta);
    }
    __syncthreads();
    {
        const int which = wv >> 2, mi = wv & 3;
        const unsigned char* Ab = lds + (which ? G1L_QS : G1L_KBS) + (mi * 16 + fr) * 272 + fq * 16;
        const unsigned char* Bb = lds + G1L_KS + fr * 272 + fq * 16;
        f32x4 acc[4];
#pragma unroll
        for (int nj = 0; nj < 4; ++nj) acc[nj] = (f32x4){0.f, 0.f, 0.f, 0.f};
#pragma unroll
        for (int k = 0; k < 4; ++k) { const bf16x8 a = *(const bf16x8*)(Ab + k * 64);
#pragma unroll
            for (int nj = 0; nj < 4; ++nj) if (nj <= mi) { const bf16x8 bb = *(const bf16x8*)(Bb + nj * 16 * 272 + k * 64); acc[nj] = __builtin_amdgcn_mfma_f32_16x16x32_bf16(a, bb, acc[nj], 0, 0, 0); } }
        bf16_t* AQ = (bf16_t*)(gout + G1_AQ);
#pragma unroll
        for (int nj = 0; nj < 4; ++nj) { const int jj = nj * 16 + fr; const float gj = gcs[jj];
#pragma unroll
            for (int j = 0; j < 4; ++j) { const int i = mi * 16 + fq * 4 + j; const float dv = acc[nj][j] * __expf(gcs[i] - gj);
                if (which == 0) { if (nj <= mi) LS[i * 64 + jj] = (jj < i) ? dv : 0.f; }
                else { const float o = (nj <= mi && jj <= i) ? dv : 0.f; AQ[i * 64 + jj] = (bf16_t)(cvtpk(o, 0.f) & 0xffffu); } } }
        const int c = tid >> 2, tg = tid & 3; const float gl = gcs[63];
        float kv[16];
#pragma unroll
        for (int e = 0; e < 16; ++e) { const int t = tg * 16 + e; kv[e] = bf2f(*(const bf16_t*)(lds + G1L_KS + t * 272 + c * 2)) * __expf(gl - gcs[t]); }
        st16_bf16(gout + G1_KDT + (c * 64 + tg * 16) * 2, kv, 1.f);
    }
    __syncthreads();
    if (wv < 4) {
        const int c = (wv & 1) * 64 + lane;
        const float* rhs = (const float*)(lds + (wv < 2 ? G1L_RU : G1L_RW)) + c;
        int vz; asm volatile("v_mov_b32 %0, 0" : "=v"(vz));
        const float* LSv = LS + vz;
        float r[64];
#pragma unroll
        for (int i = 0; i < 64; ++i) r[i] = rhs[i * 128];
#pragma unroll
        for (int i = 1; i < 64; ++i) { float a = r[i];
#pragma unroll
            for (int jq = 0; jq < (i + 3) / 4; ++jq) { const f32x4 l = *(const f32x4*)(LSv + i * 64 + jq * 4);
#pragma unroll
                for (int e = 0; e < 4; ++e) if (jq * 4 + e < i) a -= l[e] * r[jq * 4 + e]; }
            r[i] = a; }
        if (wv < 2) { unsigned char* up = gout + G1_UT + c * 128;
#pragma unroll
            for (int q = 0; q < 8; ++q) *(u32x4*)(up + q * 16) = (u32x4){cvtpk(r[8 * q], r[8 * q + 1]), cvtpk(r[8 * q + 2], r[8 * q + 3]), cvtpk(r[8 * q + 4], r[8 * q + 5]), cvtpk(r[8 * q + 6], r[8 * q + 7])}; }
        else { bf16_t* wp = (bf16_t*)(gout + G1_W) + c;
#pragma unroll
            for (int i = 0; i < 64; ++i) wp[i * 128] = (bf16_t)(cvtpk(r[i], 0.f) & 0xffffu); }
    }
    __syncthreads();
}
struct G2Regs { bf16x8 wa[4], qa[4], aa[2], kda[2][2]; u32x2 u4; float dec; };
__device__ __forceinline__ void g2_load(G2Regs& R, const Params& p, int task, int mt, int sl, int fr, int fq) {
    const unsigned char* base = p.G1OUT + (size_t)task * G1_BYTES;
#pragma unroll
    for (int k = 0; k < 4; ++k) { R.wa[k] = *(const bf16x8*)(base + G1_W + ((16 * mt + fr) * 128 + k * 32 + fq * 8) * 2); R.qa[k] = *(const bf16x8*)(base + G1_QG + ((16 * mt + fr) * 128 + k * 32 + fq * 8) * 2); }
#pragma unroll
    for (int k2 = 0; k2 < 2; ++k2) { R.aa[k2] = *(const bf16x8*)(base + G1_AQ + ((16 * mt + fr) * 64 + k2 * 32 + fq * 8) * 2);
#pragma unroll
        for (int m2 = 0; m2 < 2; ++m2) R.kda[m2][k2] = *(const bf16x8*)(base + G1_KDT + ((16 * (2 * mt + m2) + fr) * 64 + k2 * 32 + fq * 8) * 2); }
    R.u4 = *(const u32x2*)(base + G1_UT + ((16 * sl + fr) * 64 + 16 * mt + 4 * fq) * 2);
    R.dec = p.GL[task];
}
__device__ __forceinline__ void phase_g2(const Params& p, unsigned char* lds) {
    const int tid = opaque_tid(), wv = __builtin_amdgcn_readfirstlane(tid >> 6), lane = tid & 63, fr = lane & 15, fq = lane >> 4, mt = wv & 3;
    unsigned char* ST = lds; unsigned char* VT = lds + 4352;
    for (int ub = blockIdx.x; ub < 256; ub += gridDim.x) {
        const int xcd = ub & 7, idx = ub >> 3, bh = xcd * 4 + (idx >> 3), sl = idx & 7, b = bh >> 3, h = bh & 7;
        for (int i = tid; i < 4352 / 4; i += 512) ((unsigned*)ST)[i] = 0u;
        f32x4 sacc[2]; sacc[0] = (f32x4){0.f, 0.f, 0.f, 0.f}; sacc[1] = sacc[0];
        G2Regs cur, nxt;
        if (wv < 4) g2_load(nxt, p, bh * 128, mt, sl, fr, fq);
        __syncthreads();
        for (int n = 0; n < NCHUNK; ++n) {
            f32x4 dq = (f32x4){0.f, 0.f, 0.f, 0.f};
            if (wv < 4) {
                cur = nxt;
                if (n + 1 < NCHUNK) g2_load(nxt, p, bh * 128 + n + 1, mt, sl, fr, fq);
                f32x4 dw = (f32x4){0.f, 0.f, 0.f, 0.f};
#pragma unroll
                for (int k = 0; k < 4; ++k) { const bf16x8 sb = *(const bf16x8*)(ST + fr * 272 + k * 64 + fq * 16);
                    dw = __builtin_amdgcn_mfma_f32_16x16x32_bf16(cur.wa[k], sb, dw, 0, 0, 0); dq = __builtin_amdgcn_mfma_f32_16x16x32_bf16(cur.qa[k], sb, dq, 0, 0, 0); }
                const float v0 = bflo(cur.u4[0]) - dw[0], v1 = bfhi(cur.u4[0]) - dw[1], v2 = bflo(cur.u4[1]) - dw[2], v3 = bfhi(cur.u4[1]) - dw[3];
                *(u32x2*)(VT + fr * 144 + (16 * mt + 4 * fq) * 2) = (u32x2){cvtpk(v0, v1), cvtpk(v2, v3)};
            }
            __syncthreads();
            if (wv < 4) {
                const bf16x8 vb0 = *(const bf16x8*)(VT + fr * 144 + fq * 16), vb1 = *(const bf16x8*)(VT + fr * 144 + 64 + fq * 16);
                dq = __builtin_amdgcn_mfma_f32_16x16x32_bf16(cur.aa[0], vb0, dq, 0, 0, 0); dq = __builtin_amdgcn_mfma_f32_16x16x32_bf16(cur.aa[1], vb1, dq, 0, 0, 0);
                float* op = p.OG + (size_t)(b * SEQ + n * CH + 16 * mt + 4 * fq) * 1024 + h * 128 + 16 * sl + fr;
#pragma unroll
                for (int j = 0; j < 4; ++j) op[(size_t)j * 1024] = dq[j];
#pragma unroll
                for (int m2 = 0; m2 < 2; ++m2) { sacc[m2] = sacc[m2] * cur.dec;
                    sacc[m2] = __builtin_amdgcn_mfma_f32_16x16x32_bf16(cur.kda[m2][0], vb0, sacc[m2], 0, 0, 0); sacc[m2] = __builtin_amdgcn_mfma_f32_16x16x32_bf16(cur.kda[m2][1], vb1, sacc[m2], 0, 0, 0);
                    *(u32x2*)(ST + fr * 272 + (16 * (2 * mt + m2) + 4 * fq) * 2) = (u32x2){cvtpk(sacc[m2][0], sacc[m2][1]), cvtpk(sacc[m2][2], sacc[m2][3])}; }
            }
            __syncthreads();
        }
    }
}
namespace fa {
constexpr int D = 128;
constexpr int LDI = 3072;
constexpr int LDO = 2048;
constexpr float THR = 8.f;
constexpr bool WSKIP = false;
constexpr float SCALE = 0.08838834764831845f;
constexpr int NW = 8, QBLK = 32, KVBLK = 64, QB = NW * QBLK;
constexpr int SHM_V = KVBLK * D * 2, SHM_K = KVBLK * D * 2;
constexpr int LDS_BYTES = 2 * SHM_V + 2 * SHM_K + NW * 64 * 4;

using bf16 = __hip_bfloat16;
typedef short bf16x8 __attribute__((ext_vector_type(8)));
typedef short s16x4 __attribute__((ext_vector_type(4)));
typedef float f32x16 __attribute__((ext_vector_type(16)));
typedef float f32x4 __attribute__((ext_vector_type(4)));
typedef unsigned u32x4 __attribute__((ext_vector_type(4)));
template <class A, class Bt> struct same_t { static constexpr bool v = false; };
template <class A> struct same_t<A, A> { static constexpr bool v = true; };

#define KSWZ(row, colB) ((row) * 256 + ((colB) ^ (((row) & 7) << 4)))
#define SBAR() __builtin_amdgcn_sched_barrier(0)
__device__ __forceinline__ int v_st(int k, int c) { const int kk = (k & ~0xC) | ((k & 4) << 1) | ((k & 8) >> 1); return ((kk >> 3) * 4 + (c >> 5)) * 512 + ((kk & 7) * 32 + (c & 31)) * 2; }
__device__ __forceinline__ int v_rd_base(int lane) { return ((lane & 3) << 3) | (((lane >> 2) & 3) << 6) | (((lane >> 4) & 1) << 5) | (((lane >> 5) & 1) << 8); }
constexpr int v_rd_off(int d0, int ks, int half) { return d0 * 512 + ks * 4096 + half * 2048; }
__device__ __forceinline__ int crow(int r, int hi) { return (r & 3) + 8 * (r >> 2) + 4 * hi; }
__device__ __forceinline__ unsigned cvtpk(float lo, float hi) {
    unsigned r; asm volatile("v_cvt_pk_bf16_f32 %0, %1, %2" : "=v"(r) : "v"(lo), "v"(hi)); return r;
}
__device__ __forceinline__ bf16x8 pack8(f32x4 a, f32x4 b) {
    u32x4 w = {cvtpk(a[0], a[1]), cvtpk(a[2], a[3]), cvtpk(b[0], b[1]), cvtpk(b[2], b[3])};
    return *reinterpret_cast<bf16x8*>(&w);
}
template <class T> __device__ __forceinline__ bf16x8 load8(const T* p) {
    if constexpr (same_t<T, float>::v) { return pack8(*(const f32x4*)p, *(const f32x4*)(p + 4)); }
    else { return *reinterpret_cast<const bf16x8*>(p); }
}
__device__ __forceinline__ void mask_tile(f32x16& p0, f32x16& p1, int dq, unsigned W) {
    const float NEG = -__builtin_inff();
#pragma unroll
    for (int r = 0; r < 16; ++r) {
        const int c = (r & 3) + 8 * (r >> 2);
        if ((unsigned)(dq - c) >= W) p0[r] = NEG;
        if ((unsigned)(dq - c - 32) >= W) p1[r] = NEG;
    }
}
__device__ __forceinline__ void partialSM(f32x16& p0, f32x16& p1, float& m_reg, float& mn, float& alpha) {
    float pmax = p0[0]; for (int r = 1; r < 16; ++r) pmax = fmaxf(pmax, p0[r]); for (int r = 0; r < 16; ++r) pmax = fmaxf(pmax, p1[r]);
    { auto rr = __builtin_amdgcn_permlane32_swap(__float_as_uint(pmax), __float_as_uint(pmax), false, false);
      pmax = fmaxf(__uint_as_float(rr[0]), __uint_as_float(rr[1])); }
    constexpr float C2 = 1.4426950408889634f * SCALE;
    if (__builtin_expect(__all((pmax - m_reg) * SCALE <= THR), 1)) { mn = m_reg; alpha = 1.f; }
    else { mn = fmaxf(m_reg, pmax); alpha = __builtin_amdgcn_exp2f((m_reg - mn) * C2); m_reg = mn; }
    const float mnL = -mn * C2;
    for (int r = 0; r < 16; ++r) p0[r] = fmaf(p0[r], C2, mnL); for (int r = 0; r < 16; ++r) p1[r] = fmaf(p1[r], C2, mnL);
    for (int r = 0; r < 16; ++r) p0[r] = __builtin_amdgcn_exp2f(p0[r]);
}
__device__ __forceinline__ void finishSM(f32x16& p0, f32x16& p1, float alpha, float& l_reg, bf16x8& pa0, bf16x8& pa1, bf16x8& pa2, bf16x8& pa3) {
    for (int r = 0; r < 16; ++r) p1[r] = __builtin_amdgcn_exp2f(p1[r]);
    float ps = 0; for (int r = 0; r < 16; ++r) ps += p0[r]; for (int r = 0; r < 16; ++r) ps += p1[r];
    { auto rr = __builtin_amdgcn_permlane32_swap(__float_as_uint(ps), __float_as_uint(ps), false, false);
      ps = __uint_as_float(rr[0]) + __uint_as_float(rr[1]); }
    l_reg = l_reg * alpha + ps;
#define PK4(P, B_, OUT) do { unsigned a0 = cvtpk(P[B_+0], P[B_+1]), a1 = cvtpk(P[B_+2], P[B_+3]);                          \
        unsigned b0 = cvtpk(P[B_+4], P[B_+5]), b1 = cvtpk(P[B_+6], P[B_+7]);                                             \
        auto r0 = __builtin_amdgcn_permlane32_swap(a0, b0, false, false); auto r1 = __builtin_amdgcn_permlane32_swap(a1, b1, false, false); \
        u32x4 w = {r0[0], r1[0], r0[1], r1[1]}; OUT = *reinterpret_cast<bf16x8*>(&w); } while (0)
    PK4(p0, 0, pa0); PK4(p0, 8, pa1); PK4(p1, 0, pa2); PK4(p1, 8, pa3);
#undef PK4
}
template <int KB, bool SK>
__device__ __forceinline__ void qkt(f32x16& p0, f32x16& p1, const char* K_lds, int r32, int hi, const bf16x8* qr, bool act, const float* bt) {
    if (SK && !act) { const float NEG = -__builtin_inff();
#pragma unroll
        for (int r = 0; r < 16; ++r) { p0[r] = NEG; p1[r] = NEG; } return; }
    { const f32x4 a0 = *(const f32x4*)(bt), a1 = *(const f32x4*)(bt + 8), a2 = *(const f32x4*)(bt + 16), a3 = *(const f32x4*)(bt + 24);
      const f32x4 c0 = *(const f32x4*)(bt + 32), c1 = *(const f32x4*)(bt + 40), c2 = *(const f32x4*)(bt + 48), c3 = *(const f32x4*)(bt + 56);
      p0 = (f32x16){a0[0], a0[1], a0[2], a0[3], a1[0], a1[1], a1[2], a1[3], a2[0], a2[1], a2[2], a2[3], a3[0], a3[1], a3[2], a3[3]};
      p1 = (f32x16){c0[0], c0[1], c0[2], c0[3], c1[0], c1[1], c1[2], c1[3], c2[0], c2[1], c2[2], c2[3], c3[0], c3[1], c3[2], c3[3]}; }
    const char* kb[4];
#pragma unroll
    for (int dd = 0; dd < 4; ++dd) kb[dd] = K_lds + KB * SHM_K + KSWZ(r32, (dd * 16 + hi * 8) * 2);
#pragma unroll
    for (int d0 = 0; d0 < 8; ++d0) { const char* a = kb[d0 & 3] + (d0 >> 2) * 128;
        bf16x8 b0 = *reinterpret_cast<const bf16x8*>(a);
        bf16x8 b1 = *reinterpret_cast<const bf16x8*>(a + 32 * 256);
        p0 = __builtin_amdgcn_mfma_f32_32x32x16_bf16(b0, qr[d0], p0, 0, 0, 0);
        p1 = __builtin_amdgcn_mfma_f32_32x32x16_bf16(b1, qr[d0], p1, 0, 0, 0); }
}
template <int VB, bool SK>
__device__ __forceinline__ void pv_tile(f32x16* o, int vb0, bf16x8 pa0, bf16x8 pa1, bf16x8 pa2, bf16x8 pa3, bool act) {
    if (SK && !act) return;
#define TRRD(dst, off) asm volatile("ds_read_b64_tr_b16 %0, %1 offset:%2" : "=&v"(dst) : "v"(vb0), "i"(off) : "memory")
#define PV_D0(d0) do { s16x4 l0, l1, l2, l3, h0, h1, h2, h3; constexpr int b_ = VB * SHM_V + v_rd_off(d0, 0, 0);     \
        TRRD(l0, b_); TRRD(h0, b_ + 2048); TRRD(l1, b_ + 4096); TRRD(h1, b_ + 6144); TRRD(l2, b_ + 8192); TRRD(h2, b_ + 10240); TRRD(l3, b_ + 12288); TRRD(h3, b_ + 14336); \
        asm volatile("s_waitcnt lgkmcnt(0)" ::: "memory"); SBAR();                 \
        o[d0] = __builtin_amdgcn_mfma_f32_32x32x16_bf16(pa0, (bf16x8){l0[0], l0[1], l0[2], l0[3], h0[0], h0[1], h0[2], h0[3]}, o[d0], 0, 0, 0);   \
        o[d0] = __builtin_amdgcn_mfma_f32_32x32x16_bf16(pa1, (bf16x8){l1[0], l1[1], l1[2], l1[3], h1[0], h1[1], h1[2], h1[3]}, o[d0], 0, 0, 0);   \
        o[d0] = __builtin_amdgcn_mfma_f32_32x32x16_bf16(pa2, (bf16x8){l2[0], l2[1], l2[2], l2[3], h2[0], h2[1], h2[2], h2[3]}, o[d0], 0, 0, 0);   \
        o[d0] = __builtin_amdgcn_mfma_f32_32x32x16_bf16(pa3, (bf16x8){l3[0], l3[1], l3[2], l3[3], h3[0], h3[1], h3[2], h3[3]}, o[d0], 0, 0, 0); } while (0)
    PV_D0(0); PV_D0(1); PV_D0(2); PV_D0(3);
#undef PV_D0
#undef TRRD
}

template <class TIn, class TOut> struct BlockRef { const TIn* Q; const TIn* K; const TIn* V; TOut* O; int P0; };
template <class TIn> struct Seam {
    bf16x8 qr[8];
    bf16x8 st_v0, st_v1, st_k0, st_k1; f32x4 sf0, sf1, sf2, sf3;
    f32x4 tq[16];
};
__device__ __forceinline__ int swa_jlo(int P0, int W) { const int lowk = P0 - W + 1; return lowk > 0 ? lowk / KVBLK : 0; }
#define ROW(p, k0, rr) ((p) + (size_t)((k0) + (rr)) * LDI + sc)
#define VMW() asm volatile("s_waitcnt vmcnt(0)" ::: "memory")
#define VMWN(n) asm volatile("s_waitcnt vmcnt(%0)" :: "i"(n) : "memory")
#define SLOAD_H(Kp, Vp, k0) do { S.st_v0 = load8<TIn>(ROW(Vp, k0, sr)); S.st_v1 = load8<TIn>(ROW(Vp, k0, 32 + sr));              \
                         S.st_k0 = load8<TIn>(ROW(Kp, k0, sr)); S.st_k1 = load8<TIn>(ROW(Kp, k0, 32 + sr)); } while (0)
#define SWRITE_HK(bf) do { *(bf16x8*)(K_lds + (bf) * SHM_K + kws) = S.st_k0; *(bf16x8*)(K_lds + (bf) * SHM_K + kws + 32 * 256) = S.st_k1; } while (0)
#define SWRITE_HV(bf) do { *(bf16x8*)(V_lds + (bf) * SHM_V + vst0) = S.st_v0; *(bf16x8*)(V_lds + (bf) * SHM_V + vst1) = S.st_v1; } while (0)
#define SWRITE_H(bf) do { SWRITE_HV(bf); SWRITE_HK(bf); } while (0)
#define SLOAD_F(p, k0) do { S.sf0 = *(const f32x4*)ROW(p, k0, sr); S.sf1 = *(const f32x4*)(ROW(p, k0, sr) + 4);                \
                            S.sf2 = *(const f32x4*)ROW(p, k0, 32 + sr); S.sf3 = *(const f32x4*)(ROW(p, k0, 32 + sr) + 4); } while (0)
#define SWRITE_KF(bf) do { *(bf16x8*)(K_lds + (bf) * SHM_K + kws) = pack8(S.sf0, S.sf1); *(bf16x8*)(K_lds + (bf) * SHM_K + kws + 32 * 256) = pack8(S.sf2, S.sf3); } while (0)
#define SWRITE_VF(bf) do { *(bf16x8*)(V_lds + (bf) * SHM_V + vst0) = pack8(S.sf0, S.sf1); *(bf16x8*)(V_lds + (bf) * SHM_V + vst1) = pack8(S.sf2, S.sf3); } while (0)
template <class TIn, class TOut>
__device__ __forceinline__ void causal_swa_prime(const BlockRef<TIn, TOut>& cur, int W, char* lds, Seam<TIn>& S) {
    constexpr bool F32 = same_t<TIn, float>::v;
    const int tid = opaque_tid(), wid = __builtin_amdgcn_readfirstlane(tid >> 6), lane = tid & 63, r32 = lane & 31, hi = lane >> 5;
    const int sr = tid >> 4, sc = (tid & 15) * 8, kws = KSWZ(sr, sc * 2); char* K_lds = lds + 2 * SHM_V;
    const int kb0 = swa_jlo(cur.P0, W) * KVBLK;
    for (int d0 = 0; d0 < 8; ++d0) S.qr[d0] = load8<TIn>(cur.Q + (size_t)(wid * QBLK + r32) * LDI + d0 * 16 + hi * 8);
    if constexpr (F32) { SLOAD_F((const float*)cur.K, kb0); VMW(); SWRITE_KF(0); SBAR(); SLOAD_F((const float*)cur.V, kb0); }
    else { SLOAD_H(cur.K, cur.V, kb0); VMW(); SWRITE_HK(0); }
    __syncthreads();
}
template <class TIn, class TOut>
__device__ __forceinline__ void causal_swa_block(const BlockRef<TIn, TOut>& cur, const BlockRef<TIn, TOut>& nxt, int skv, int W, char* lds, Seam<TIn>& S, const float* bias_l, const float* onorm) {
    constexpr bool F32 = same_t<TIn, float>::v;
    const int tid = opaque_tid(), wid = __builtin_amdgcn_readfirstlane(tid >> 6), lane = tid & 63, r32 = lane & 31, hi = lane >> 5;
    const int j_lo = swa_jlo(cur.P0, W);
    int j_hi = (cur.P0 + QB - 1) / KVBLK + 1; if (j_hi > skv / KVBLK) j_hi = skv / KVBLK;
    const int NT = j_hi - j_lo;
    const int kbn = swa_jlo(nxt.P0, W) * KVBLK;
    const int qlo = cur.P0 + wid * QBLK, qm = qlo + r32 - 4 * hi;
    char* V_lds = lds; char* K_lds = lds + 2 * SHM_V;
    float* ws = (float*)(lds + 2 * SHM_V + 2 * SHM_K) + wid * 64; float* li_l = ws, * al_l = ws + 32;
    float m_reg = -1e30f, l_reg = 0; f32x16 o[4] = {};
    const int sr = tid >> 4, sc = (tid & 15) * 8, vst0 = v_st(sr, sc), vst1 = v_st(32 + sr, sc), kws = KSWZ(sr, sc * 2);
    const int vb0 = (int)(uintptr_t)V_lds + v_rd_base(lane);
    const TIn* Kh = cur.K; const TIn* Vh = cur.V;
#define RESC(a) do { if (__any((a) < 1.f)) { if (hi == 0) al_l[r32] = (a); asm volatile("s_waitcnt lgkmcnt(0)" ::: "memory");              \
                     for (int d_ = 0; d_ < 4; ++d_) for (int r = 0; r < 16; ++r) o[d_][r] *= al_l[crow(r, hi)]; } } while (0)
#define KBASE(t) ((j_lo + (t)) * KVBLK)
#define BT(t) (bias_l + KBASE(t) + 4 * hi)
#define ACT(t) (KBASE(t) <= qlo + QBLK - 1 && KBASE(t) + KVBLK - 1 >= qlo - W + 1)
#define MASKT(P0_, P1_, t) do { const int kb_ = KBASE(t); if ((!SK || ACT(t)) && (kb_ + KVBLK - 1 > qlo || kb_ <= qlo + QBLK - 1 - W)) mask_tile(P0_, P1_, qm - kb_, (unsigned)W); } while (0)
    constexpr int NQL = F32 ? 16 : 8;
    constexpr bool SK = WSKIP && !F32;
#define SEAM_K0() do { VMWN(NQL); if constexpr (F32) { SWRITE_KF(0); SBAR(); SLOAD_F((const float*)nxt.V, kbn); } else { SWRITE_HK(0); } SBAR(); } while (0)
    f32x16 pA0, pA1, pB0, pB1; float mnA, mnB, alA, alB; bf16x8 pa0, pa1, pa2, pa3;
    if constexpr (F32) { VMW(); SWRITE_VF(0); SBAR(); } else { SWRITE_HV(0); SBAR(); }
    if (NT > 1) { if constexpr (F32) SLOAD_F((const float*)Kh, KBASE(1)); else SLOAD_H(Kh, Vh, KBASE(1)); }
    SBAR(); qkt<0, SK>(pA0, pA1, K_lds, r32, hi, S.qr, ACT(0), BT(0));
    if constexpr (F32) { if (NT > 1) { VMW(); SWRITE_KF(1); SBAR(); SLOAD_F((const float*)Vh, KBASE(1)); } }
    MASKT(pA0, pA1, 0); partialSM(pA0, pA1, m_reg, mnA, alA);
    if (NT > 1) { VMW(); if constexpr (F32) { SWRITE_VF(1); SBAR(); if (NT > 2) SLOAD_F((const float*)Kh, KBASE(2)); } else SWRITE_H(1); }
    __syncthreads();
#define HALF_STEP(PX0, PX1, mnX, alX, PY0, PY1, alY, t, KB, VB, SB) do {                                                      \
        SBAR(); qkt<KB, SK>(PX0, PX1, K_lds, r32, hi, S.qr, ACT(t), BT(t));                                             \
        finishSM(PY0, PY1, alY, l_reg, pa0, pa1, pa2, pa3); SBAR();                                                           \
        if ((t) + 1 < NT) { if constexpr (F32) { VMW(); SWRITE_KF(SB); SBAR(); SLOAD_F((const float*)Vh, KBASE((t) + 1)); }  \
                            else { SLOAD_H(Kh, Vh, KBASE((t) + 1)); } SBAR(); }                                               \
        pv_tile<VB, SK>(o, vb0, pa0, pa1, pa2, pa3, ACT((t) - 1)); MASKT(PX0, PX1, (t)); partialSM(PX0, PX1, m_reg, mnX, alX);                                        \
        __syncthreads();                                                                                                      \
        if ((t) + 1 < NT) { VMW(); if constexpr (F32) { SWRITE_VF(SB); SBAR(); if ((t) + 2 < NT) SLOAD_F((const float*)Kh, KBASE((t) + 2)); } \
                            else { SWRITE_H(SB); } }                                                                          \
        RESC(alX); __syncthreads(); } while (0)
    for (int t = 1; t + 1 < NT; t += 2) {
        HALF_STEP(pB0, pB1, mnB, alB, pA0, pA1, alA, t, 1, 0, 0);
        HALF_STEP(pA0, pA1, mnA, alA, pB0, pB1, alB, t + 1, 0, 1, 1);
    }
    const bool even = (NT & 1) == 0;
    if (even) { SBAR(); qkt<1, SK>(pB0, pB1, K_lds, r32, hi, S.qr, ACT(NT - 1), BT(NT - 1)); SBAR(); }
#define QROW(e) (nxt.Q + (size_t)(wid * QBLK + r32) * LDI + ((e) >> 1) * 16 + hi * 8 + ((e) & 1) * 4)
    if constexpr (F32) { SLOAD_F((const float*)nxt.K, kbn); SBAR();
#pragma unroll
        for (int e = 0; e < 8; ++e) S.tq[e] = *(const f32x4*)QROW(e); }
    else { SLOAD_H(nxt.K, nxt.V, kbn); SBAR();
#pragma unroll
        for (int d0 = 0; d0 < 8; ++d0) S.qr[d0] = load8<TIn>(nxt.Q + (size_t)(wid * QBLK + r32) * LDI + d0 * 16 + hi * 8); }
    SBAR();
    finishSM(pA0, pA1, alA, l_reg, pa0, pa1, pa2, pa3); SBAR();
    if constexpr (F32) {
#pragma unroll
        for (int e = 8; e < 16; ++e) S.tq[e] = *(const f32x4*)QROW(e); SBAR(); }
#undef QROW
    pv_tile<0, SK>(o, vb0, pa0, pa1, pa2, pa3, ACT(even ? NT - 2 : NT - 1));
    if (even) { MASKT(pB0, pB1, NT - 1); partialSM(pB0, pB1, m_reg, mnB, alB); __syncthreads(); RESC(alB);
        finishSM(pB0, pB1, alB, l_reg, pa0, pa1, pa2, pa3); SBAR(); pv_tile<1, SK>(o, vb0, pa0, pa1, pa2, pa3, ACT(NT - 1)); }
    SBAR(); SEAM_K0();
    if (hi == 0) li_l[r32] = l_reg; asm volatile("s_waitcnt lgkmcnt(0)" ::: "memory");
    float rli[16];
#pragma unroll
    for (int r = 0; r < 16; ++r) rli[r] = __builtin_amdgcn_rcpf(li_l[crow(r, hi)]);
    TOut* Ow = cur.O + (size_t)(wid * QBLK) * LDO;
#pragma unroll
    for (int r = 0; r < 16; ++r) { const int orow = crow(r, hi);
        float v4[4]; float ss = 0.f;
#pragma unroll
        for (int d0 = 0; d0 < 4; ++d0) { v4[d0] = o[d0][r] * rli[r]; ss += v4[d0] * v4[d0]; }
        ss += __shfl_xor(ss, 1); ss += __shfl_xor(ss, 2); ss += __shfl_xor(ss, 4); ss += __shfl_xor(ss, 8); ss += __shfl_xor(ss, 16);
        const float rn = __builtin_amdgcn_rsqf(ss * (1.f / 128.f) + 1e-6f);
#pragma unroll
        for (int d0 = 0; d0 < 4; ++d0) { const float v = v4[d0] * rn * onorm[d0 * 32 + r32];
            const float vn = __shfl_xor(v, 1);
            if ((r32 & 1) == 0) *(unsigned*)(Ow + (size_t)orow * LDO + d0 * 32 + r32) = cvtpk(v, vn); } }
    if constexpr (F32) {
#pragma unroll
        for (int d0 = 0; d0 < 8; ++d0) S.qr[d0] = pack8(S.tq[2 * d0], S.tq[2 * d0 + 1]); }
    __syncthreads();
#undef RESC
#undef KBASE
#undef BT
#undef ACT
#undef MASKT
#undef SEAM_K0
#undef HALF_STEP
}
#undef ROW
#undef VMW
}
__device__ __forceinline__ fa::BlockRef<bf16_t, bf16_t> fox_ref(int Li, int pass, const bf16_t* QKV, bf16_t* O) {
    using namespace fa;
    BlockRef<bf16_t, bf16_t> r; const int xcd = Li & 7, k = Li >> 3, bh = (k >> 4) * 8 + xcd, x = k & 15, qb = pass ? 31 - x : x, b = bh >> 3, h = bh & 7;
    r.Q = QKV + ((size_t)(b * SEQ + qb * QB)) * LDI + h * 128; r.K = QKV + (size_t)(b * SEQ) * LDI + 1024 + h * 128; r.V = r.K + 1024;
    r.O = O + ((size_t)(b * SEQ + qb * QB)) * LDO + h * 128; r.P0 = qb * QB; return r;
}
__device__ __forceinline__ void phase_attn(const bf16_t* __restrict__ QKV, bf16_t* __restrict__ O, const float* __restrict__ BIAS, const float* __restrict__ onorm, char* lds) {
    using namespace fa;
    float* bias_l = (float*)(lds + LDS_BYTES);
    constexpr int total = 512;
    int L = blockIdx.x; if (L >= total) return;
    const int stride = gridDim.x, tid = opaque_tid();
    int pass = 0, loaded = -1; int Wr; asm volatile("s_mov_b32 %0, 8192" : "=s"(Wr));
    BlockRef<bf16_t, bf16_t> cur = fox_ref(L, 0, QKV, O);
    Seam<bf16_t> S;
    causal_swa_prime<bf16_t, bf16_t>(cur, Wr, lds, S);
    for (;;) {
        const bool more_pass = pass == 0, more_item = L + stride < total, last = !more_pass && !more_item;
        int passn = pass + 1, Ln = L;
        if (!more_pass) { passn = 0; Ln = more_item ? L + stride : L; }
        const BlockRef<bf16_t, bf16_t> nxt = last ? cur : fox_ref(Ln, passn, QKV, O);
        const int bh = ((L >> 3) >> 4) * 8 + (L & 7);
        if (bh != loaded) { const float* src = BIAS + (size_t)bh * SEQ + tid * 4;
            const int wq = __builtin_amdgcn_readfirstlane(tid >> 6);
#pragma unroll
            for (int i = 0; i < 4; ++i) __builtin_amdgcn_global_load_lds((const unsigned*)(src + i * 2048), (PG8_LAS unsigned*)(bias_l + i * 2048 + wq * 256), 16, 0, 0);
            asm volatile("s_waitcnt vmcnt(0)" ::: "memory");
            loaded = bh; __syncthreads(); }
        causal_swa_block<bf16_t, bf16_t>(cur, nxt, SEQ, Wr, lds, S, bias_l, onorm);
        if (last) break;
        cur = nxt; pass = passn; L = Ln;
    }
}

#ifndef PH_MASK
#define PH_MASK 0xFFFF
#endif
#define PH(b) if constexpr ((PH_MASK >> (b)) & 1)
__global__ void __launch_bounds__(512, 2) fwd_megakernel(Params p) {
    extern __shared__ __attribute__((aligned(16))) unsigned char shm[];
    cg::grid_group grid = cg::this_grid();
    PG8_LAS unsigned char* glds = (PG8_LAS unsigned char*)shm;
    float* tile = (float*)shm;
    pg8::StaticOrder S;
    PH(0) phase_prologue(p, shm);
    grid.sync();
#define FFN_BLOCK(f) do { const float* xin = (f) ? p.out : p.x; \
        PH(1) phase_norm(xin, p.norm_g + ((f) ? 2 : 0) * DM, p.MOD, (f) ? 6 : 0, (f) ? 7 : 1, p.H); \
        grid.sync(); \
        PH(2) { pg8::Gemm g{p.H, p.WGU, MTOK, 2 * DFF, DM}; S.init(g.M, g.N, (int)gridDim.x, (int)blockIdx.x); EpiSwiGLU E{p.HID}; \
          pg8::gemm_phase<EpiSwiGLU, pg8::StaticOrder, false>(glds, g, S, E, nullptr); } \
        grid.sync(); \
        PH(3) { pg8::Gemm g{p.HID, p.WD, MTOK, DM, DFF}; S.init(g.M, g.N, (int)gridDim.x, (int)blockIdx.x); EpiResid E{xin, p.out, p.MOD + ((f) ? 8 : 2) * DM, 0.5f}; \
          pg8::gemm_phase<EpiResid, pg8::StaticOrder, false>(glds, g, S, E, nullptr); } \
        grid.sync(); } while (0)
    FFN_BLOCK(0);
    PH(1) phase_norm(p.out, p.norm_g + DM, p.MOD, 3, 4, p.H);
    grid.sync();
    PH(4) { pg8::Gemm g{p.H, p.WIN, MTOK, NPROJ, DM}; S.init(g.M, g.N, (int)gridDim.x, (int)blockIdx.x); EpiProj E{p.QKVF, p.QKVG, p.Z, p.SMALL};
      pg8::gemm_phase<EpiProj, pg8::StaticOrder, false>(glds, g, S, E, nullptr); }
    grid.sync();
    PH(5) for (int t = blockIdx.x; t < 32 + NTASK; t += gridDim.x) { if (t < 32) cumsum_task(p, t, (float*)shm); else g1_task(p, t - 32, shm); }
    grid.sync();
    PH(6) phase_g2(p, shm);
    PH(7) phase_attn(p.QKVF, p.H, p.BIAS, p.fox_out_norm, (char*)shm);
    grid.sync();
    PH(8) phase_gdn_out(p);
    PH(8) for (int t = blockIdx.x; t < CT_GU + CT_D; t += gridDim.x) conv_ffn(p, 1, t, tile);
    grid.sync();
    PH(9) { pg8::Gemm g{p.H, p.WOUT, MTOK, DM, DM}; S.init(g.M, g.N, (int)gridDim.x, (int)blockIdx.x); EpiResid E{p.out, p.out, p.MOD + 5 * DM, 1.0f};
      pg8::gemm_phase<EpiResid, pg8::StaticOrder, false>(glds, g, S, E, nullptr); }
    grid.sync();
    FFN_BLOCK(1);
    PH(10) phase_final_norm(p.out, p.final_norm);
}

extern "C" void kernel_launch(void* const* d_in, const int* in_sizes, int n_in, void* d_out, int out_size, void* d_ws, size_t ws_size, hipStream_t stream) {
    static int grid_blocks = 0;
    constexpr size_t O_WGU = 0, O_WD = O_WGU + (size_t)2 * DFF * DM * 2, O_WIN = O_WD + (size_t)DM * DFF * 2, O_WOUT = O_WIN + (size_t)NPROJ * DM * 2,
        O_MOD = O_WOUT + (size_t)DM * DM * 2, O_H = O_MOD + (size_t)NB * NMOD * 4, O_QKVF = O_H + (size_t)MTOK * DM * 2, O_QKVG = O_QKVF + (size_t)MTOK * 3072 * 2,
        O_Z = O_QKVG + (size_t)MTOK * 3072 * 2, O_SMALL = O_Z + (size_t)MTOK * 1024 * 2, O_BIAS = O_SMALL + (size_t)MTOK * 32 * 4, O_GL = O_BIAS + (size_t)32 * SEQ * 4,
        O_G1 = O_GL + (size_t)NTASK * 4, O_END = O_G1 + (size_t)NTASK * G1_BYTES;
    if (grid_blocks == 0) {
        if (n_in != 17 || out_size != MTOK * DM || ws_size < O_END) { fprintf(stderr, "kernel_launch: unexpected shapes (n_in %d out %d ws %zu need %zu)\n", n_in, out_size, ws_size, (size_t)O_END); grid_blocks = -1; return; }
        int dev = 0, cus = 0, per_cu = 0;
        hipGetDevice(&dev); hipDeviceGetAttribute(&cus, hipDeviceAttributeMultiprocessorCount, dev);
        if (hipFuncSetAttribute((const void*)fwd_megakernel, hipFuncAttributeMaxDynamicSharedMemorySize, LDS_TOTAL) != hipSuccess) { fprintf(stderr, "kernel_launch: hipFuncSetAttribute failed\n"); grid_blocks = -1; return; }
        if (hipOccupancyMaxActiveBlocksPerMultiprocessor(&per_cu, (const void*)fwd_megakernel, 512, LDS_TOTAL) != hipSuccess || per_cu < 1) { fprintf(stderr, "kernel_launch: occupancy query failed (%d)\n", per_cu); per_cu = 1; }
        (void)hipGetLastError();
        grid_blocks = cus * per_cu;
    }
    if (grid_blocks < 0) return;
    Params p{};
    const float** in = (const float**)&p;
    for (int i = 0; i < 17; ++i) in[i] = (const float*)d_in[i];
    unsigned char* ws = (unsigned char*)d_ws;
    p.out = (float*)d_out;
    p.WGU = (bf16_t*)(ws + O_WGU); p.WD = (bf16_t*)(ws + O_WD); p.WIN = (bf16_t*)(ws + O_WIN); p.WOUT = (bf16_t*)(ws + O_WOUT);
    p.H = (bf16_t*)(ws + O_H); p.QKVF = (bf16_t*)(ws + O_QKVF); p.QKVG = (bf16_t*)(ws + O_QKVG); p.Z = (bf16_t*)(ws + O_Z); p.HID = (bf16_t*)(ws + O_QKVF);
    p.MOD = (float*)(ws + O_MOD); p.SMALL = (float*)(ws + O_SMALL); p.BIAS = (float*)(ws + O_BIAS); p.GL = (float*)(ws + O_GL); p.OG = (float*)(ws + O_QKVG);
    p.G1OUT = ws + O_G1;
    void* args[] = {&p};
    hipError_t e = hipLaunchCooperativeKernel((const void*)fwd_megakernel, dim3(grid_blocks), dim3(512), args, LDS_TOTAL, stream);
    if (e != hipSuccess) fprintf(stderr, "cooperative launch failed: %s (grid %d)\n", hipGetErrorString(e), grid_blocks);
}
```

```cpp
#include <hip/hip_runtime.h>
#include <hip/hip_bf16.h>
#include <hip/hip_cooperative_groups.h>
#include <cstdio>
#include <cstdint>
namespace cg = cooperative_groups;

constexpr int MTOK = 32768, DM = 2048, DFF = 5632, SEQ = 8192, NB = 4, NHD = 8, HD = 128, NMOD = 18432;
constexpr int NPROJ = 7424;
constexpr int NCHUNK = 128, CH = 64, NTASK = NB * NHD * NCHUNK;
constexpr size_t G1_UT = 0, G1_W = 16384, G1_QG = 32768, G1_KDT = 49152, G1_AQ = 65536, G1_BYTES = 73728;
constexpr int LDS_TOTAL = 139264;
__device__ __forceinline__ int opaque_tid() { int t; asm volatile("v_mov_b32 %0, %1" : "=v"(t) : "v"(threadIdx.x)); return t; }
namespace pg8 {
#define PG8_LAS __attribute__((address_space(3)))
typedef unsigned short bf16_t;
typedef short bf16x8 __attribute__((ext_vector_type(8)));
typedef float f32x4 __attribute__((ext_vector_type(4)));
typedef unsigned u32x4 __attribute__((ext_vector_type(4)));
constexpr int BM = 256, BK = 64, HALF = 128, HTB = HALF * BK * 2  , STAGE_BYTES = 8 * HTB, NXCD = 8, WGM = 8;

__host__ __device__ __forceinline__ int lds_byte(int r, int c) { const int st = (r >> 4) * 2 + (c >> 5), rr = r & 15, cc = c & 31, ob = rr * 64 + cc * 2; return st * 1024 + (ob ^ (((ob >> 9) & 1) << 5)); }
__host__ __device__ __forceinline__ void stage_rc(int b, int& R, int& C) { const int st = b / 1024, sb = b % 1024, swz = sb ^ (((sb >> 9) & 1) << 5); R = (st >> 1) * 16 + swz / 64; C = (st & 1) * 32 + (swz % 64) / 2; }
__host__ __device__ __forceinline__ int perm32(int rho) { const int n = rho >> 4, i = rho & 15; return 8 * (i >> 2) + 4 * n + (i & 3); }

struct Unit { int pm, pn; };
struct Gemm { const bf16_t* A; const bf16_t* Bt; int M, N, K; };

struct StaticOrder {
    int nM, nN, nwg, G, c;
    __host__ __device__ void init(int M, int N, int G_, int c_) { nM = M / BM; nN = N / BM; nwg = nM * nN; G = G_; c = c_; }
    __host__ __device__ bool next(int i, Unit& u) const {
        const long L = (long)i * G + c; if (L >= nwg) return false;
        int wgid = (int)L; { const int q = nwg / NXCD, r = nwg % NXCD, xcd = wgid % NXCD, off = wgid / NXCD; wgid = (xcd < r ? xcd * (q + 1) : r * (q + 1) + (xcd - r) * q) + off; }
        const int nig = WGM * nN, gid = wgid / nig, fm = gid * WGM, gsz = (nM - fm) < WGM ? (nM - fm) : WGM;
        u.pm = fm + ((wgid % nig) % gsz); u.pn = (wgid % nig) / gsz; return true;
    }
    __device__ __forceinline__ void a_ready(const Unit&) const {}
    __device__ __forceinline__ void done(const Unit&) const {}
};
template <class Epi, class Sched, bool STAMP = false>
__device__ __forceinline__ void gemm_phase(PG8_LAS unsigned char* lds, const Gemm g, const Sched& S, const Epi& E, unsigned long long* stamps) {
    const int tid = opaque_tid(), wid = __builtin_amdgcn_readfirstlane(tid >> 6), lane = tid & 63, wr = wid >> 2, wc = wid & 3, fr = lane & 15, fq = lane >> 4;
    const int K = g.K, nt = K / BK;
    int ts_lo = 0, ts_hi = 0, nts = 0; const unsigned long long rt_entry = STAMP ? (unsigned long long)wall_clock64() : 0ull;
#define PG8_STAMP() do { if (STAMP && wid == 0 && nts < 64) { const unsigned long long _c = (unsigned long long)clock64(); \
        ts_lo = (lane == nts) ? (int)(unsigned)_c : ts_lo; ts_hi = (lane == nts) ? (int)(unsigned)(_c >> 32) : ts_hi; ++nts; } } while (0)
    PG8_STAMP();
    unsigned voffA[2], voffB[2];
#pragma unroll
    for (int i = 0; i < 2; ++i) { int R, C; stage_rc(tid * 16 + i * 8192, R, C); const int Rb = Epi::PERM ? ((R & ~31) + perm32(R & 31)) : R;
        voffA[i] = (unsigned)(R * K + C) * 2u; voffB[i] = (unsigned)(Rb * K + C) * 2u; }
    const size_t kstep = (size_t)(BK * 2);
    const size_t hstep = (size_t)HALF * K * 2;
    const size_t tstep = 2 * hstep;
    const unsigned ldsw = (unsigned)wid * 1024u;
    const int aoff = lds_byte(wr * 64 + fr, fq * 8), boff = lds_byte(wc * 32 + fr, fq * 8);
#define PG8_SA(b, h) (((b) * 2 + (h)) * HTB)
#define PG8_SB(b, h) ((4 + (b) * 2 + (h)) * HTB)
#define PG8_STAGE(bufoff, gbase, voff) do { _Pragma("unroll") for (int _i = 0; _i < 2; ++_i) \
        __builtin_amdgcn_global_load_lds((const unsigned*)((const char*)(gbase) + (voff)[_i]), (PG8_LAS unsigned*)(lds + (bufoff) + ldsw + _i * 8192), 16, 0, 0); } while (0)
#define PG8_LDA(dst, b, h) do { _Pragma("unroll") for (int m = 0; m < 4; ++m) _Pragma("unroll") for (int k = 0; k < 2; ++k) dst[m][k] = *(const PG8_LAS bf16x8*)(lds + PG8_SA(b, h) + aoff + m * 2048 + k * 1024); } while (0)
#define PG8_LDB(dst, b, h) do { _Pragma("unroll") for (int n = 0; n < 2; ++n) _Pragma("unroll") for (int k = 0; k < 2; ++k) dst[n][k] = *(const PG8_LAS bf16x8*)(lds + PG8_SB(b, h) + boff + n * 2048 + k * 1024); } while (0)
#define PG8_MMA(ai, bj, At, Bt) do { __builtin_amdgcn_s_setprio(1); _Pragma("unroll") for (int m = 0; m < 4; ++m) _Pragma("unroll") for (int n = 0; n < 2; ++n) _Pragma("unroll") for (int k = 0; k < 2; ++k) \
        acc[ai][bj][m][n] = __builtin_amdgcn_mfma_f32_16x16x32_bf16(Bt[n][k], At[m][k], acc[ai][bj][m][n], 0, 0, 0); __builtin_amdgcn_s_setprio(0); } while (0)
#define PG8_WAIT_V(n) asm volatile("s_waitcnt vmcnt(" #n ")" ::: "memory")
#define PG8_WAIT_L(n) asm volatile("s_waitcnt lgkmcnt(" #n ")" ::: "memory")
#define PG8_BAR __builtin_amdgcn_s_barrier()
#define PG8_SCHED __builtin_amdgcn_sched_barrier(0)
    Unit cur, nxt; int ui = 0;
    if (!S.next(0, cur)) return;
    f32x4 acc[2][2][4][2];
#pragma unroll
    for (int a = 0; a < 2; ++a)
#pragma unroll
        for (int b = 0; b < 2; ++b)
#pragma unroll
            for (int m = 0; m < 4; ++m)
#pragma unroll
                for (int n = 0; n < 2; ++n) acc[a][b][m][n] = (f32x4){0.f, 0.f, 0.f, 0.f};
    bf16x8 At[4][2], B0[2][2], B1[2][2];
    const char* cA = (const char*)g.A + (size_t)cur.pm * tstep; const char* cB = (const char*)g.Bt + (size_t)cur.pn * tstep;
    S.a_ready(cur);
    PG8_STAGE(PG8_SB(0, 0), cB, voffB); PG8_STAGE(PG8_SA(0, 0), cA, voffA); PG8_STAGE(PG8_SB(0, 1), cB + hstep, voffB); PG8_STAGE(PG8_SA(0, 1), cA + hstep, voffA);
    if (wr == 1) PG8_BAR;
    PG8_WAIT_V(4); PG8_BAR;
    PG8_STAGE(PG8_SB(1, 0), cB + kstep, voffB); PG8_STAGE(PG8_SA(1, 0), cA + kstep, voffA); PG8_STAGE(PG8_SB(1, 1), cB + hstep + kstep, voffB);
    PG8_WAIT_V(6); PG8_BAR;
    PG8_STAMP();
    for (;;) {
        const bool has_next = S.next(ui + 1, nxt);
        const char* nA = has_next ? (const char*)g.A + (size_t)nxt.pm * tstep : cA; const char* nB = has_next ? (const char*)g.Bt + (size_t)nxt.pn * tstep : cB;
        for (int t = 0; t < nt; t += 2) {
            const bool last = (t == nt - 2);
            const char* a1 = cA + (size_t)(t + 1) * kstep;
            const char* a2 = last ? nA : cA + (size_t)(t + 2) * kstep; const char* b2 = last ? nB : cB + (size_t)(t + 2) * kstep;
            const char* a3 = a2 + kstep; const char* b3 = b2 + kstep;
            if (last && has_next) S.a_ready(nxt);
            PG8_LDB(B0, 0, 0); PG8_SCHED; PG8_LDA(At, 0, 0); PG8_STAGE(PG8_SA(1, 1), a1 + hstep, voffA);
            PG8_WAIT_L(8); PG8_BAR; PG8_WAIT_L(0); PG8_MMA(0, 0, At, B0); PG8_BAR; PG8_SCHED;
            PG8_LDB(B1, 0, 1); PG8_STAGE(PG8_SB(0, 0), b2, voffB);
            PG8_BAR; PG8_WAIT_L(0); PG8_MMA(0, 1, At, B1); PG8_BAR;
            PG8_LDA(At, 0, 1); PG8_STAGE(PG8_SA(0, 0), a2, voffA);
            PG8_BAR; PG8_WAIT_L(0); PG8_MMA(1, 0, At, B0); PG8_BAR; PG8_SCHED;
            PG8_STAGE(PG8_SB(0, 1), b2 + hstep, voffB);
            PG8_WAIT_V(6); PG8_BAR; PG8_MMA(1, 1, At, B1); PG8_BAR;
            PG8_LDB(B0, 1, 0); PG8_SCHED; PG8_LDA(At, 1, 0); PG8_STAGE(PG8_SA(0, 1), a2 + hstep, voffA);
            PG8_WAIT_L(8); PG8_BAR; PG8_WAIT_L(0); PG8_MMA(0, 0, At, B0); PG8_BAR; PG8_SCHED;
            PG8_LDB(B1, 1, 1); PG8_STAGE(PG8_SB(1, 0), b3, voffB);
            PG8_BAR; PG8_WAIT_L(0); PG8_MMA(0, 1, At, B1); PG8_BAR;
            PG8_LDA(At, 1, 1); PG8_STAGE(PG8_SA(1, 0), a3, voffA);
            PG8_BAR; PG8_WAIT_L(0); PG8_MMA(1, 0, At, B0); PG8_BAR; PG8_SCHED;
            PG8_STAGE(PG8_SB(1, 1), b3 + hstep, voffB);
            PG8_WAIT_V(6); PG8_BAR; PG8_MMA(1, 1, At, B1); PG8_BAR;
        }
        PG8_STAMP();
        if constexpr (!Epi::AFTER_DRAIN) { E(acc, cur, wr, wc, fr, fq); S.done(cur); }
        PG8_STAMP();
        if (!has_next) break;
#pragma unroll
        for (int a = 0; a < 2; ++a)
#pragma unroll
            for (int b = 0; b < 2; ++b)
#pragma unroll
                for (int m = 0; m < 4; ++m)
#pragma unroll
                    for (int n = 0; n < 2; ++n) acc[a][b][m][n] = (f32x4){0.f, 0.f, 0.f, 0.f};
        cur = nxt; cA = nA; cB = nB; ++ui;
    }
    PG8_WAIT_V(0);
    if (wr == 0) PG8_BAR;
    PG8_BAR;
    if constexpr (Epi::AFTER_DRAIN) { E.fused(acc, cur, wr, wc, fr, fq, lds, wid, lane); S.done(cur); }
    PG8_STAMP();
    if (STAMP && wid == 0) { stamps[lane] = lane < nts ? (((unsigned long long)(unsigned)ts_hi << 32) | (unsigned)ts_lo) : 0ull;
        if (lane == 62) stamps[62] = rt_entry; if (lane == 63) stamps[63] = (unsigned long long)wall_clock64(); }
#undef PG8_STAMP
#undef PG8_SA
#undef PG8_SB
#undef PG8_STAGE
#undef PG8_LDA
#undef PG8_LDB
#undef PG8_MMA
#undef PG8_WAIT_V
#undef PG8_WAIT_L
#undef PG8_BAR
#undef PG8_SCHED
}
}
using pg8::bf16_t; using pg8::bf16x8; using pg8::f32x4; using pg8::u32x4; using pg8::Unit;
typedef unsigned u32x2 __attribute__((ext_vector_type(2)));

constexpr size_t O_WGU = 0, O_WD = O_WGU + (size_t)2 * DFF * DM * 2, O_WIN = O_WD + (size_t)DM * DFF * 2, O_WOUT = O_WIN + (size_t)NPROJ * DM * 2,
    O_MOD = O_WOUT + (size_t)DM * DM * 2, O_H = O_MOD + (size_t)NB * NMOD * 4, O_QKVF = O_H + (size_t)MTOK * DM * 2, O_QKVG = O_QKVF + (size_t)MTOK * 3072 * 2,
    O_Z = O_QKVG + (size_t)MTOK * 3072 * 2, O_SMALL = O_Z + (size_t)MTOK * 1024 * 2, O_BIAS = O_SMALL + (size_t)MTOK * 32 * 4, O_GL = O_BIAS + (size_t)32 * SEQ * 4,
    O_G1 = O_GL + (size_t)NTASK * 4, O_END = O_G1 + (size_t)NTASK * G1_BYTES, O_HID = O_QKVF, O_OG = O_QKVG;
struct Params {
    const float *x, *c, *ada_w, *ada_b, *norm_g, *wg, *wu, *wd, *w_in, *w_out, *fox_f_bias, *fox_out_norm, *gdn_conv, *gdn_A_log, *gdn_dt_bias, *gdn_out_norm, *final_norm;
    float* out;
    unsigned char* ws;
    __device__ __forceinline__ bf16_t* WGU_() const { return (bf16_t*)(ws + O_WGU); }
    __device__ __forceinline__ bf16_t* WD_() const { return (bf16_t*)(ws + O_WD); }
    __device__ __forceinline__ bf16_t* WIN_() const { return (bf16_t*)(ws + O_WIN); }
    __device__ __forceinline__ bf16_t* WOUT_() const { return (bf16_t*)(ws + O_WOUT); }
    __device__ __forceinline__ bf16_t* H_() const { return (bf16_t*)(ws + O_H); }
    __device__ __forceinline__ bf16_t* QKVF_() const { return (bf16_t*)(ws + O_QKVF); }
    __device__ __forceinline__ bf16_t* QKVG_() const { return (bf16_t*)(ws + O_QKVG); }
    __device__ __forceinline__ bf16_t* Z_() const { return (bf16_t*)(ws + O_Z); }
    __device__ __forceinline__ bf16_t* HID_() const { return (bf16_t*)(ws + O_HID); }
    __device__ __forceinline__ float* MOD_() const { return (float*)(ws + O_MOD); }
    __device__ __forceinline__ float* SMALL_() const { return (float*)(ws + O_SMALL); }
    __device__ __forceinline__ float* BIAS_() const { return (float*)(ws + O_BIAS); }
    __device__ __forceinline__ float* GL_() const { return (float*)(ws + O_GL); }
    __device__ __forceinline__ float* OG_() const { return (float*)(ws + O_OG); }
    __device__ __forceinline__ unsigned char* G1OUT_() const { return ws + O_G1; }
};

__device__ __forceinline__ unsigned cvtpk(float lo, float hi) { unsigned r; asm volatile("v_cvt_pk_bf16_f32 %0, %1, %2" : "=v"(r) : "v"(lo), "v"(hi)); return r; }
__device__ __forceinline__ float bf2f(unsigned short b) { return __uint_as_float(((unsigned)b) << 16); }
__device__ __forceinline__ float bflo(unsigned w) { return __uint_as_float(w << 16); }
__device__ __forceinline__ float bfhi(unsigned w) { return __uint_as_float(w & 0xffff0000u); }
__device__ __forceinline__ float wave_sum(float v) { for (int o = 32; o; o >>= 1) v += __shfl_xor(v, o); return v; }
__device__ __forceinline__ float silu_f(float v) { return v * __builtin_amdgcn_rcpf(1.f + __expf(-v)); }
__device__ __forceinline__ float softplus_f(float v) { return fmaxf(v, 0.f) + log1pf(__expf(-fabsf(v))); }

struct EpiSwiGLU { static constexpr bool PERM = true, AFTER_DRAIN = false; bf16_t* O;
    __device__ __forceinline__ void operator()(const f32x4 (&acc)[2][2][4][2], const Unit& u, int wr, int wc, int fr, int fq) const {
        const int row0 = u.pm * 256 + wr * 64 + fr, col0 = u.pn * 128 + wc * 32 + 8 * fq;
#pragma unroll
        for (int ai = 0; ai < 2; ++ai)
#pragma unroll
            for (int m = 0; m < 4; ++m) { bf16_t* rowp = O + (size_t)(row0 + ai * 128 + m * 16) * DFF + col0;
                float h[8];
#pragma unroll
                for (int n = 0; n < 2; ++n)
#pragma unroll
                    for (int j = 0; j < 4; ++j) h[n * 4 + j] = silu_f(acc[ai][0][m][n][j]) * acc[ai][1][m][n][j];
                *(u32x4*)rowp = (u32x4){cvtpk(h[0], h[1]), cvtpk(h[2], h[3]), cvtpk(h[4], h[5]), cvtpk(h[6], h[7])}; }
    }
};
struct EpiResid { static constexpr bool PERM = false, AFTER_DRAIN = false; const float* xin; float* out; const float* gate; float s;
    __device__ __forceinline__ void operator()(const f32x4 (&acc)[2][2][4][2], const Unit& u, int wr, int wc, int fr, int fq) const {
        const int row0 = u.pm * 256 + wr * 64 + fr, col0 = u.pn * 256 + wc * 32 + 4 * fq, b = u.pm >> 5;
        f32x4 gv[2][2];
#pragma unroll
        for (int bj = 0; bj < 2; ++bj)
#pragma unroll
            for (int n = 0; n < 2; ++n) gv[bj][n] = *(const f32x4*)(gate + (size_t)b * NMOD + col0 + bj * 128 + n * 16) * s;
#pragma unroll
        for (int ai = 0; ai < 2; ++ai)
#pragma unroll
            for (int m = 0; m < 4; ++m) { const size_t ro = (size_t)(row0 + ai * 128 + m * 16) * DM + col0;
#pragma unroll
                for (int bj = 0; bj < 2; ++bj)
#pragma unroll
                    for (int n = 0; n < 2; ++n) { const f32x4 xv = *(const f32x4*)(xin + ro + bj * 128 + n * 16);
                        *(f32x4*)(out + ro + bj * 128 + n * 16) = xv + gv[bj][n] * acc[ai][bj][m][n]; } }
    }
};
struct EpiProj { static constexpr bool PERM = true, AFTER_DRAIN = false; bf16_t *qkvf, *qkvg, *z; float* small;
    __device__ __forceinline__ void operator()(const f32x4 (&acc)[2][2][4][2], const Unit& u, int wr, int wc, int fr, int fq) const {
        const int row0 = u.pm * 256 + wr * 64 + fr;
        if (u.pn == 28) {
            if (wc == 0) {
#pragma unroll
                for (int ai = 0; ai < 2; ++ai)
#pragma unroll
                    for (int m = 0; m < 4; ++m) { float* rp = small + (size_t)(row0 + ai * 128 + m * 16) * 32 + 8 * fq;
                        *(f32x4*)rp = acc[ai][0][m][0]; *(f32x4*)(rp + 4) = acc[ai][0][m][1]; }
            }
            return;
        }
        if (u.pn < 12) {
            const int b = u.pm >> 5, s0 = (u.pm & 31) * 256 + wr * 64 + fr;
#pragma unroll
            for (int bj = 0; bj < 2; ++bj) { const int hh = u.pn * 2 + bj, which = hh >> 3, h = hh & 7;
                bf16_t* hb = qkvf + ((size_t)((which * NB + b) * NHD + h) * SEQ) * 128 + wc * 32 + 8 * fq;
#pragma unroll
                for (int ai = 0; ai < 2; ++ai)
#pragma unroll
                    for (int m = 0; m < 4; ++m) { const f32x4 v0 = acc[ai][bj][m][0], v1 = acc[ai][bj][m][1];
                        *(u32x4*)(hb + (size_t)(s0 + ai * 128 + m * 16) * 128) = (u32x4){cvtpk(v0[0], v0[1]), cvtpk(v0[2], v0[3]), cvtpk(v1[0], v1[1]), cvtpk(v1[2], v1[3])}; } }
            return;
        }
        bf16_t* base; int ld, ct;
        if (u.pn < 24) { base = qkvg; ld = 3072; ct = u.pn - 12; } else { base = z; ld = 1024; ct = u.pn - 24; }
        const int col0 = ct * 256 + wc * 32 + 8 * fq;
#pragma unroll
        for (int ai = 0; ai < 2; ++ai)
#pragma unroll
            for (int m = 0; m < 4; ++m) { bf16_t* rowp = base + (size_t)(row0 + ai * 128 + m * 16) * ld + col0;
#pragma unroll
                for (int bj = 0; bj < 2; ++bj) { const f32x4 v0 = acc[ai][bj][m][0], v1 = acc[ai][bj][m][1];
                    *(u32x4*)(rowp + bj * 128) = (u32x4){cvtpk(v0[0], v0[1]), cvtpk(v0[2], v0[3]), cvtpk(v1[0], v1[1]), cvtpk(v1[2], v1[3])}; } }
    }
};
__device__ __forceinline__ void mod_task(const Params& p, int t, const float* cond, float* red) {
    const int tid = opaque_tid(), wv = tid >> 6, lane = tid & 63, col = t * 64 + lane;
    float a0 = 0.f, a1 = 0.f, a2 = 0.f, a3 = 0.f;
    const float* w = p.ada_w + (size_t)(wv * 256) * NMOD + col;
    const float* cd = cond + wv * 256;
#pragma unroll 32
    for (int k = 0; k < 256; ++k) { const float v = w[(size_t)k * NMOD]; a0 += cd[k] * v; a1 += cd[2048 + k] * v; a2 += cd[4096 + k] * v; a3 += cd[6144 + k] * v; }
    red[(wv * 4 + 0) * 64 + lane] = a0; red[(wv * 4 + 1) * 64 + lane] = a1; red[(wv * 4 + 2) * 64 + lane] = a2; red[(wv * 4 + 3) * 64 + lane] = a3;
    __syncthreads();
    if (tid < 256) { const int b = tid >> 6; float s = p.ada_b[col];
#pragma unroll
        for (int w8 = 0; w8 < 8; ++w8) s += red[(w8 * 4 + b) * 64 + lane];
        p.MOD_()[(size_t)b * NMOD + col] = s; }
    __syncthreads();
}
__device__ __forceinline__ const float* wmap_col(int mode, const float* s0, const float* s1, int r) {
    if (mode == 0) return s0 + r;
    if (mode == 1) { const int pn = r >> 8, bj = (r >> 7) & 1, u = r & 127; return (bj ? s1 : s0) + 128 * pn + u; }
    int c;
    if (r < 3072) c = r; else if (r < 6144) c = 3080 + (r - 3072); else if (r < 7168) c = 6168 + (r - 6144);
    else if (r < 7176) c = 3072 + (r - 7168); else if (r < 7184) c = 6152 + (r - 7176); else if (r < 7192) c = 6160 + (r - 7184); else return nullptr;
    return s0 + c;
}
constexpr int CT_GU = 176 * 32, CT_D = 32 * 88, CT_IN = 116 * 32, CT_OUT = 32 * 32;
struct ConvJob { const float* s0; const float* s1; bf16_t* dst; int mode, ld, K, ntn, idx; };
__device__ __forceinline__ ConvJob conv_job_ffn(const Params& p, int l, int idx) {
    ConvJob j;
    if (idx < CT_GU) { j.s0 = p.wg + (size_t)l * DM * DFF; j.s1 = p.wu + (size_t)l * DM * DFF; j.dst = p.WGU_(); j.mode = 1; j.ld = DFF; j.K = DM; j.ntn = 176; j.idx = idx; }
    else { j.s0 = p.wd + (size_t)l * DFF * DM; j.s1 = nullptr; j.dst = p.WD_(); j.mode = 0; j.ld = DM; j.K = DFF; j.ntn = 32; j.idx = idx - CT_GU; }
    return j;
}
__device__ __forceinline__ ConvJob conv_job0(const Params& p, int t) {
    constexpr int NT0 = CT_GU + CT_D, NT1 = NT0 + CT_IN;
    if (t < NT0) return conv_job_ffn(p, 0, t);
    ConvJob j; j.s1 = nullptr; j.K = DM;
    if (t < NT1) { j.s0 = p.w_in; j.dst = p.WIN_(); j.mode = 2; j.ld = 7192; j.ntn = 116; j.idx = t - NT0; }
    else { j.s0 = p.w_out; j.dst = p.WOUT_(); j.mode = 0; j.ld = DM; j.ntn = 32; j.idx = t - NT1; }
    return j;
}
__device__ __forceinline__ void conv_load(const ConvJob& j, int tid, float (&v)[8]) {
    const int n0 = (j.idx % j.ntn) * 64, k0 = (j.idx / j.ntn) * 64, n = tid & 63, kq = tid >> 6;
    const float* cp = wmap_col(j.mode, j.s0, j.s1, n0 + n);
#pragma unroll
    for (int i = 0; i < 8; ++i) v[i] = cp ? cp[(size_t)(k0 + i * 8 + kq) * j.ld] : 0.f;
}
__device__ __forceinline__ void conv_store(const ConvJob& j, int tid, const float (&v)[8], float* tile) {
    const int n0 = (j.idx % j.ntn) * 64, k0 = (j.idx / j.ntn) * 64, n = tid & 63, kq = tid >> 6;
#pragma unroll
    for (int i = 0; i < 8; ++i) tile[n * 65 + i * 8 + kq] = v[i];
    __syncthreads();
    const int n2 = tid >> 3, kg = tid & 7; const float* tp = tile + n2 * 65 + kg * 8;
    *(u32x4*)(j.dst + (size_t)(n0 + n2) * j.K + k0 + kg * 8) = (u32x4){cvtpk(tp[0], tp[1]), cvtpk(tp[2], tp[3]), cvtpk(tp[4], tp[5]), cvtpk(tp[6], tp[7])};
    __syncthreads();
}
template <int LIST> __device__ __forceinline__ void conv_run(const Params& p, int NT, float* tile) {
    const int tid = opaque_tid(), G = gridDim.x;
    for (int t = blockIdx.x; t < NT; t += 4 * G) {
        float v[4][8]; ConvJob j[4];
#pragma unroll
        for (int q = 0; q < 4; ++q) { const int tq = t + q * G; if (tq < NT) { j[q] = LIST ? conv_job_ffn(p, 1, tq) : conv_job0(p, tq); conv_load(j[q], tid, v[q]); } }
#pragma unroll
        for (int q = 0; q < 4; ++q) { const int tq = t + q * G; if (tq < NT) conv_store(j[q], tid, v[q], tile); }
    }
}
__device__ __forceinline__ void phase_prologue(const Params& p, unsigned char* lds) {
    float* cond = (float*)lds; float* red = cond + 8192; float* tile = (float*)lds;
    const int tid = opaque_tid();
    if ((int)blockIdx.x < 288) {
        for (int i = tid; i < 8192; i += 512) { const float c = p.c[i]; cond[i] = c / (1.f + __expf(-c)); }
        __syncthreads();
        for (int t = blockIdx.x; t < 288; t += gridDim.x) mod_task(p, t, cond, red);
    }
    conv_run<0>(p, CT_GU + CT_D + CT_IN + CT_OUT, tile);
}
__device__ __forceinline__ void phase_norm(const float* xin, const float* g, const float* mod, int shift_idx, int scale_idx, bf16_t* h) {
    const int tid = opaque_tid(), lane = tid & 63, gw = blockIdx.x * 8 + (tid >> 6), GW = gridDim.x * 8;
    for (int row = gw; row < MTOK; row += GW) {
        const int b = row >> 13; const float* xr = xin + (size_t)row * DM;
        f32x4 v[8]; float ss = 0.f;
#pragma unroll
        for (int i = 0; i < 8; ++i) { v[i] = *(const f32x4*)(xr + 4 * (lane + 64 * i)); ss += v[i][0] * v[i][0] + v[i][1] * v[i][1] + v[i][2] * v[i][2] + v[i][3] * v[i][3]; }
        ss = wave_sum(ss); const float r = __builtin_amdgcn_rsqf(ss * (1.f / DM) + 1e-6f);
        const float* sh = mod + (size_t)b * NMOD + shift_idx * DM; const float* sc = mod + (size_t)b * NMOD + scale_idx * DM;
#pragma unroll
        for (int i = 0; i < 8; ++i) { const int col = 4 * (lane + 64 * i);
            const f32x4 gg = *(const f32x4*)(g + col), s1 = *(const f32x4*)(sc + col), s0 = *(const f32x4*)(sh + col);
            const f32x4 y = v[i] * r * gg * (s1 + 1.f) + s0;
            *(u32x2*)(h + (size_t)row * DM + col) = (u32x2){cvtpk(y[0], y[1]), cvtpk(y[2], y[3])}; }
    }
}
__device__ __forceinline__ void phase_final_norm(float* x, const float* g) {
    const int tid = opaque_tid(), lane = tid & 63, gw = blockIdx.x * 8 + (tid >> 6), GW = gridDim.x * 8;
    for (int row = gw; row < MTOK; row += GW) {
        float* xr = x + (size_t)row * DM;
        f32x4 v[8]; float ss = 0.f;
#pragma unroll
        for (int i = 0; i < 8; ++i) { v[i] = *(const f32x4*)(xr + 4 * (lane + 64 * i)); ss += v[i][0] * v[i][0] + v[i][1] * v[i][1] + v[i][2] * v[i][2] + v[i][3] * v[i][3]; }
        ss = wave_sum(ss); const float r = __builtin_amdgcn_rsqf(ss * (1.f / DM) + 1e-6f);
#pragma unroll
        for (int i = 0; i < 8; ++i) { const int col = 4 * (lane + 64 * i); *(f32x4*)(xr + col) = v[i] * r * *(const f32x4*)(g + col); }
    }
}
__device__ __forceinline__ void phase_gdn_out(const Params& p) {
    const int tid = opaque_tid(), lane = tid & 63, half = lane >> 5, l32 = lane & 31, gw = blockIdx.x * 8 + (tid >> 6), GW = gridDim.x * 8;
    const f32x4 gn = *(const f32x4*)(p.gdn_out_norm + 4 * l32);
    for (int it = gw; it < MTOK * NHD / 2; it += GW) {
        const int grp = it * 2 + half, row = grp >> 3, h = grp & 7;
        const f32x4 v = *(const f32x4*)(p.OG_() + (size_t)row * 1024 + h * 128 + 4 * l32);
        const u32x2 zz = *(const u32x2*)(p.Z_() + (size_t)row * 1024 + h * 128 + 4 * l32);
        float ss = v[0] * v[0] + v[1] * v[1] + v[2] * v[2] + v[3] * v[3];
        ss += __shfl_xor(ss, 1); ss += __shfl_xor(ss, 2); ss += __shfl_xor(ss, 4); ss += __shfl_xor(ss, 8); ss += __shfl_xor(ss, 16);
        const float r = __builtin_amdgcn_rsqf(ss * (1.f / 128.f) + 1e-6f);
        const float y0 = v[0] * r * gn[0] * silu_f(bflo(zz[0])), y1 = v[1] * r * gn[1] * silu_f(bfhi(zz[0]));
        const float y2 = v[2] * r * gn[2] * silu_f(bflo(zz[1])), y3 = v[3] * r * gn[3] * silu_f(bfhi(zz[1]));
        *(u32x2*)(p.H_() + (size_t)row * DM + 1024 + h * 128 + 4 * l32) = (u32x2){cvtpk(y0, y1), cvtpk(y2, y3)};
    }
}
__device__ __forceinline__ void cumsum_task(const Params& p, int bh, float* wsum) {
    const int tid = opaque_tid(), wv = tid >> 6, lane = tid & 63, b = bh >> 3, h = bh & 7;
    const float fb = p.fox_f_bias[h];
    float loc[16]; float run = 0.f;
#pragma unroll
    for (int i = 0; i < 16; ++i) { const float xv = p.SMALL_()[(size_t)(b * SEQ + tid * 16 + i) * 32 + h] + fb; run += fminf(xv, 0.f) - log1pf(__expf(-fabsf(xv))); loc[i] = run; }
    float inc = run;
#pragma unroll
    for (int o = 1; o < 64; o <<= 1) { const float t = __shfl_up(inc, o); if (lane >= o) inc += t; }
    if (lane == 63) wsum[wv] = inc;
    __syncthreads();
    float off = inc - run;
    for (int w8 = 0; w8 < wv; ++w8) off += wsum[w8];
#pragma unroll
    for (int i = 0; i < 16; ++i) p.BIAS_()[(size_t)bh * SEQ + tid * 16 + i] = -(off + loc[i]) * 11.313708498984761f;
    __syncthreads();
}
constexpr int G1L_QS = 0, G1L_KS = 17408, G1L_KBS = 34816, G1L_RU = 52224, G1L_RW = 84992, G1L_LS = 117760, G1L_GC = 134144, G1L_BETA = 134400;
__device__ __forceinline__ void g1_conv_part(const Params& p, int part, int b, int h, int t0, int tok, int ch0, float (&y)[16]) {
    const int colbase = part * 1024 + h * 128 + ch0;
#pragma unroll
    for (int e = 0; e < 16; ++e) y[e] = 0.f;
#pragma unroll
    for (int kk = 0; kk < 4; ++kk) {
        const int tt = t0 + tok - 3 + kk;
        u32x4 x0 = (u32x4){0u, 0u, 0u, 0u}, x1 = x0;
        if (tt >= 0) { const bf16_t* xp = p.QKVG_() + (size_t)(b * SEQ + tt) * 3072 + colbase; x0 = *(const u32x4*)xp; x1 = *(const u32x4*)(xp + 8); }
        const float* wp = p.gdn_conv + (size_t)kk * 3072 + colbase;
        const f32x4 w0 = *(const f32x4*)wp, w1 = *(const f32x4*)(wp + 4), w2 = *(const f32x4*)(wp + 8), w3 = *(const f32x4*)(wp + 12);
        y[0] += w0[0] * bflo(x0[0]); y[1] += w0[1] * bfhi(x0[0]); y[2] += w0[2] * bflo(x0[1]); y[3] += w0[3] * bfhi(x0[1]);
        y[4] += w1[0] * bflo(x0[2]); y[5] += w1[1] * bfhi(x0[2]); y[6] += w1[2] * bflo(x0[3]); y[7] += w1[3] * bfhi(x0[3]);
        y[8] += w2[0] * bflo(x1[0]); y[9] += w2[1] * bfhi(x1[0]); y[10] += w2[2] * bflo(x1[1]); y[11] += w2[3] * bfhi(x1[1]);
        y[12] += w3[0] * bflo(x1[2]); y[13] += w3[1] * bfhi(x1[2]); y[14] += w3[2] * bflo(x1[3]); y[15] += w3[3] * bfhi(x1[3]);
    }
#pragma unroll
    for (int e = 0; e < 16; ++e) y[e] = silu_f(y[e]);
}
__device__ __forceinline__ void st16_bf16(unsigned char* dst, const float (&y)[16], float s) {
    *(u32x4*)dst = (u32x4){cvtpk(y[0] * s, y[1] * s), cvtpk(y[2] * s, y[3] * s), cvtpk(y[4] * s, y[5] * s), cvtpk(y[6] * s, y[7] * s)};
    *(u32x4*)(dst + 16) = (u32x4){cvtpk(y[8] * s, y[9] * s), cvtpk(y[10] * s, y[11] * s), cvtpk(y[12] * s, y[13] * s), cvtpk(y[14] * s, y[15] * s)};
}
__device__ __forceinline__ void st16_f32(float* dst, const float (&y)[16], float s) {
#pragma unroll
    for (int q = 0; q < 4; ++q) *(f32x4*)(dst + 4 * q) = (f32x4){y[4 * q] * s, y[4 * q + 1] * s, y[4 * q + 2] * s, y[4 * q + 3] * s};
}
__device__ __forceinline__ void g1_task(const Params& p, int task, unsigned char* lds) {
    const int tid = opaque_tid(), wv = __builtin_amdgcn_readfirstlane(tid >> 6), lane = tid & 63, fr = lane & 15, fq = lane >> 4;
    const int bh = task >> 7, n = task & 127, b = bh >> 3, h = bh & 7, t0 = n * CH;
    float* gcs = (float*)(lds + G1L_GC); float* betas = (float*)(lds + G1L_BETA); float* LS = (float*)(lds + G1L_LS);
    unsigned char* gout = p.G1OUT_() + (size_t)task * G1_BYTES;
    if (wv == 0) {
        const size_t row = (size_t)(b * SEQ + t0 + lane);
        const float al = p.SMALL_()[row * 32 + 8 + h], bl = p.SMALL_()[row * 32 + 16 + h];
        const float g = -__expf(p.gdn_A_log[h]) * softplus_f(al + p.gdn_dt_bias[h]);
        float inc = g;
#pragma unroll
        for (int o = 1; o < 64; o <<= 1) { const float t = __shfl_up(inc, o); if (lane >= o) inc += t; }
        gcs[lane] = inc; betas[lane] = 1.f / (1.f + __expf(-bl));
        if (lane == 63) p.GL_()[task] = __expf(inc);
    }
    __syncthreads();
    {
        const int tok = tid >> 3, ch0 = (tid & 7) * 16;
        const float gc = gcs[tok], beta = betas[tok], eg = __expf(gc);
        float y[16];
        g1_conv_part(p, 1, b, h, t0, tok, ch0, y);
        { float ss = 0.f;
#pragma unroll
          for (int e = 0; e < 16; ++e) ss += y[e] * y[e];
          ss += __shfl_xor(ss, 1); ss += __shfl_xor(ss, 2); ss += __shfl_xor(ss, 4);
          const float inv = __builtin_amdgcn_rsqf(ss + 1e-6f);
          st16_bf16(lds + G1L_KS + tok * 272 + ch0 * 2, y, inv);
          st16_bf16(lds + G1L_KBS + tok * 272 + ch0 * 2, y, inv * beta);
          st16_f32((float*)(lds + G1L_RW) + tok * 128 + ch0, y, inv * beta * eg); }
        g1_conv_part(p, 0, b, h, t0, tok, ch0, y);
        { float ss = 0.f;
#pragma unroll
          for (int e = 0; e < 16; ++e) ss += y[e] * y[e];
          ss += __shfl_xor(ss, 1); ss += __shfl_xor(ss, 2); ss += __shfl_xor(ss, 4);
          const float inv = __builtin_amdgcn_rsqf(ss + 1e-6f) * 0.08838834764831845f;
          st16_bf16(lds + G1L_QS + tok * 272 + ch0 * 2, y, inv);
          st16_bf16(gout + G1_QG + (tok * 128 + ch0) * 2, y, inv * eg); }
        g1_conv_part(p, 2, b, h, t0, tok, ch0, y);
        st16_f32((float*)(lds + G1L_RU) + tok * 128 + ch0, y, beta);
    }
    __syncthreads();
    {
        const int which = wv >> 2, mi = wv & 3;
        const unsigned char* Ab = lds + (which ? G1L_QS : G1L_KBS) + (mi * 16 + fr) * 272 + fq * 16;
        const unsigned char* Bb = lds + G1L_KS + fr * 272 + fq * 16;
        f32x4 acc[4];
#pragma unroll
        for (int nj = 0; nj < 4; ++nj) acc[nj] = (f32x4){0.f, 0.f, 0.f, 0.f};
#pragma unroll
        for (int k = 0; k < 4; ++k) { const bf16x8 a = *(const bf16x8*)(Ab + k * 64);
#pragma unroll
            for (int nj = 0; nj < 4; ++nj) if (nj <= mi) { const bf16x8 bb = *(const bf16x8*)(Bb + nj * 16 * 272 + k * 64); acc[nj] = __builtin_amdgcn_mfma_f32_16x16x32_bf16(a, bb, acc[nj], 0, 0, 0); } }
        bf16_t* AQ = (bf16_t*)(gout + G1_AQ);
#pragma unroll
        for (int nj = 0; nj < 4; ++nj) { const int jj = nj * 16 + fr; const float gj = gcs[jj];
#pragma unroll
            for (int j = 0; j < 4; ++j) { const int i = mi * 16 + fq * 4 + j; const float dv = acc[nj][j] * __expf(gcs[i] - gj);
                if (which == 0) { if (nj <= mi) LS[i * 64 + jj] = (jj < i) ? dv : 0.f; }
                else { const float o = (nj <= mi && jj <= i) ? dv : 0.f; AQ[i * 64 + jj] = (bf16_t)(cvtpk(o, 0.f) & 0xffffu); } } }
        const int c = tid >> 2, tg = tid & 3; const float gl = gcs[63];
        float kv[16];
#pragma unroll
        for (int e = 0; e < 16; ++e) { const int t = tg * 16 + e; kv[e] = bf2f(*(const bf16_t*)(lds + G1L_KS + t * 272 + c * 2)) * __expf(gl - gcs[t]); }
        st16_bf16(gout + G1_KDT + (c * 64 + tg * 16) * 2, kv, 1.f);
    }
    __syncthreads();
    if (wv < 4) {
        const int c = (wv & 1) * 64 + lane;
        const float* rhs = (const float*)(lds + (wv < 2 ? G1L_RU : G1L_RW)) + c;
        int vz; asm volatile("v_mov_b32 %0, 0" : "=v"(vz));
        const float* LSv = LS + vz;
        float r[64];
#pragma unroll
        for (int i = 0; i < 64; ++i) r[i] = rhs[i * 128];
#pragma unroll
        for (int i = 1; i < 64; ++i) { float a = r[i];
#pragma unroll
            for (int jq = 0; jq < (i + 3) / 4; ++jq) { const f32x4 l = *(const f32x4*)(LSv + i * 64 + jq * 4);
#pragma unroll
                for (int e = 0; e < 4; ++e) if (jq * 4 + e < i) a -= l[e] * r[jq * 4 + e]; }
            r[i] = a; }
        if (wv < 2) { unsigned char* up = gout + G1_UT + c * 128;
#pragma unroll
            for (int q = 0; q < 8; ++q) *(u32x4*)(up + q * 16) = (u32x4){cvtpk(r[8 * q], r[8 * q + 1]), cvtpk(r[8 * q + 2], r[8 * q + 3]), cvtpk(r[8 * q + 4], r[8 * q + 5]), cvtpk(r[8 * q + 6], r[8 * q + 7])}; }
        else { bf16_t* wp = (bf16_t*)(gout + G1_W) + c;
#pragma unroll
            for (int i = 0; i < 64; ++i) wp[i * 128] = (bf16_t)(cvtpk(r[i], 0.f) & 0xffffu); }
    }
    __syncthreads();
}
struct G2Regs { bf16x8 wa[4], qa[4], aa[2], kda[2][2]; u32x2 u4; float dec; };
__device__ __forceinline__ void g2_load(G2Regs& R, const Params& p, int task, int mt, int sl, int fr, int fq) {
    const unsigned char* base = p.G1OUT_() + (size_t)task * G1_BYTES;
#pragma unroll
    for (int k = 0; k < 4; ++k) { R.wa[k] = *(const bf16x8*)(base + G1_W + ((16 * mt + fr) * 128 + k * 32 + fq * 8) * 2); R.qa[k] = *(const bf16x8*)(base + G1_QG + ((16 * mt + fr) * 128 + k * 32 + fq * 8) * 2); }
#pragma unroll
    for (int k2 = 0; k2 < 2; ++k2) { R.aa[k2] = *(const bf16x8*)(base + G1_AQ + ((16 * mt + fr) * 64 + k2 * 32 + fq * 8) * 2);
#pragma unroll
        for (int m2 = 0; m2 < 2; ++m2) R.kda[m2][k2] = *(const bf16x8*)(base + G1_KDT + ((16 * (2 * mt + m2) + fr) * 64 + k2 * 32 + fq * 8) * 2); }
    R.u4 = *(const u32x2*)(base + G1_UT + ((16 * sl + fr) * 64 + 16 * mt + 4 * fq) * 2);
    R.dec = p.GL_()[task];
}
#define G2_WARMN 4
#define G2_DMA(ptr) do { unsigned sv_; asm volatile("s_mov_b32 %0, m0\n\ts_mov_b32 m0, %2\n\ts_nop 0\n\tglobal_load_lds_dword %1, off\n\ts_mov_b32 m0, %0" : "=&s"(sv_) : "v"(ptr), "s"(m0v) : "memory"); } while (0)
__device__ __forceinline__ void g2_consume(G2Regs& cur, G2Regs& nxt, f32x4 (&sacc)[2], const Params& p, unsigned char* ST, unsigned char* VT,
                                           int n, int bh, int sl, int b, int h, int wv, int lane, int fr, int fq, int mt, unsigned m0v) {
    f32x4 dq = (f32x4){0.f, 0.f, 0.f, 0.f}, dw = dq;
    if (false && wv >= 4 && n + G2_WARMN < NCHUNK) {
        const int li = (wv - 4) * 64 + lane; const unsigned char* w_ = p.G1OUT_() + (size_t)(bh * 128 + n + G2_WARMN) * G1_BYTES;
        const unsigned char* a0_ = w_ + G1_W + li * 128; G2_DMA(a0_);
        if (li < 192) { const unsigned char* a1_ = a0_ + 32768; G2_DMA(a1_); }
        if (li < 16) { const unsigned char* a2_ = w_ + G1_UT + (16 * sl + li) * 128; G2_DMA(a2_); }
    }
    if (wv < 4) {
        if (n + 1 < NCHUNK) g2_load(nxt, p, bh * 128 + n + 1, mt, sl, fr, fq);
        asm volatile("" ::: "memory");
#pragma unroll
        for (int k = 0; k < 4; ++k) { const bf16x8 sb = *(const bf16x8*)(ST + fr * 272 + k * 64 + fq * 16);
            dw = __builtin_amdgcn_mfma_f32_16x16x32_bf16(cur.wa[k], sb, dw, 0, 0, 0); dq = __builtin_amdgcn_mfma_f32_16x16x32_bf16(cur.qa[k], sb, dq, 0, 0, 0); }
        const float v0 = bflo(cur.u4[0]) - dw[0], v1 = bfhi(cur.u4[0]) - dw[1], v2 = bflo(cur.u4[1]) - dw[2], v3 = bfhi(cur.u4[1]) - dw[3];
        *(u32x2*)(VT + fr * 144 + (16 * mt + 4 * fq) * 2) = (u32x2){cvtpk(v0, v1), cvtpk(v2, v3)};
    }
    __syncthreads();
    if (wv < 4) {
        const bf16x8 vb0 = *(const bf16x8*)(VT + fr * 144 + fq * 16), vb1 = *(const bf16x8*)(VT + fr * 144 + 64 + fq * 16);
        dq = __builtin_amdgcn_mfma_f32_16x16x32_bf16(cur.aa[0], vb0, dq, 0, 0, 0); dq = __builtin_amdgcn_mfma_f32_16x16x32_bf16(cur.aa[1], vb1, dq, 0, 0, 0);
        float* op = p.OG_() + (size_t)(b * SEQ + n * CH + 16 * mt + 4 * fq) * 1024 + h * 128 + 16 * sl + fr;
#pragma unroll
        for (int j = 0; j < 4; ++j) op[(size_t)j * 1024] = dq[j];
#pragma unroll
        for (int m2 = 0; m2 < 2; ++m2) { sacc[m2] = sacc[m2] * cur.dec;
            sacc[m2] = __builtin_amdgcn_mfma_f32_16x16x32_bf16(cur.kda[m2][0], vb0, sacc[m2], 0, 0, 0); sacc[m2] = __builtin_amdgcn_mfma_f32_16x16x32_bf16(cur.kda[m2][1], vb1, sacc[m2], 0, 0, 0);
            *(u32x2*)(ST + fr * 272 + (16 * (2 * mt + m2) + 4 * fq) * 2) = (u32x2){cvtpk(sacc[m2][0], sacc[m2][1]), cvtpk(sacc[m2][2], sacc[m2][3])}; }
    }
    __syncthreads();
}
__device__ __forceinline__ void phase_g2(const Params& p, unsigned char* lds) {
    const int tid = opaque_tid(), wv = __builtin_amdgcn_readfirstlane(tid >> 6), lane = tid & 63, fr = lane & 15, fq = lane >> 4, mt = wv & 3;
    const unsigned m0v = (unsigned)__builtin_amdgcn_readfirstlane((int)(uintptr_t)(lds + 10752 + (wv & 3) * 256));
    unsigned char* ST = lds; unsigned char* VT = lds + 4352;
    for (int ub = blockIdx.x; ub < 256; ub += gridDim.x) {
        const int xcd = ub & 7, idx = ub >> 3, bh = xcd * 4 + (idx >> 3), sl = idx & 7, b = bh >> 3, h = bh & 7;
        for (int i = tid; i < 4352 / 4; i += 512) ((unsigned*)ST)[i] = 0u;
        f32x4 sacc[2]; sacc[0] = (f32x4){0.f, 0.f, 0.f, 0.f}; sacc[1] = sacc[0];
        G2Regs A, B;
        if (wv < 4) g2_load(A, p, bh * 128, mt, sl, fr, fq);
        __syncthreads();
#pragma unroll 1
        for (int n = 0; n < NCHUNK; n += 2) {
            g2_consume(A, B, sacc, p, ST, VT, n, bh, sl, b, h, wv, lane, fr, fq, mt, m0v);
            g2_consume(B, A, sacc, p, ST, VT, n + 1, bh, sl, b, h, wv, lane, fr, fq, mt, m0v);
        }
        asm volatile("s_waitcnt vmcnt(0)" ::: "memory");
        __syncthreads();
    }
}
namespace fa {
constexpr int D = 128;
constexpr int LDI = 128;
constexpr int LDO = 2048;
constexpr float THR = 8.f;
constexpr bool WSKIP = false;
constexpr float SCALE = 0.08838834764831845f;
constexpr int NW = 8, QBLK = 32, KVBLK = 64, QB = NW * QBLK;
constexpr int SHM_V = KVBLK * D * 2, SHM_K = KVBLK * D * 2;
constexpr int LDS_BYTES = 2 * SHM_V + 2 * SHM_K + NW * 64 * 4;

using bf16 = __hip_bfloat16;
typedef short bf16x8 __attribute__((ext_vector_type(8)));
typedef short s16x4 __attribute__((ext_vector_type(4)));
typedef float f32x16 __attribute__((ext_vector_type(16)));
typedef float f32x4 __attribute__((ext_vector_type(4)));
typedef unsigned u32x4 __attribute__((ext_vector_type(4)));
template <class A, class Bt> struct same_t { static constexpr bool v = false; };
template <class A> struct same_t<A, A> { static constexpr bool v = true; };

#define KSWZ(row, colB) ((row) * 256 + ((colB) ^ (((row) & 7) << 4)))
#define SBAR() __builtin_amdgcn_sched_barrier(0)
__device__ __forceinline__ int v_st(int k, int c) { const int kk = (k & ~0xC) | ((k & 4) << 1) | ((k & 8) >> 1); return ((kk >> 3) * 4 + (c >> 5)) * 512 + ((kk & 7) * 32 + (c & 31)) * 2; }
__device__ __forceinline__ int v_rd_base(int lane) { return ((lane & 3) << 3) | (((lane >> 2) & 3) << 6) | (((lane >> 4) & 1) << 5) | (((lane >> 5) & 1) << 8); }
constexpr int v_rd_off(int d0, int ks, int half) { return d0 * 512 + ks * 4096 + half * 2048; }
__device__ __forceinline__ int crow(int r, int hi) { return (r & 3) + 8 * (r >> 2) + 4 * hi; }
__device__ __forceinline__ unsigned cvtpk(float lo, float hi) {
    unsigned r; asm volatile("v_cvt_pk_bf16_f32 %0, %1, %2" : "=v"(r) : "v"(lo), "v"(hi)); return r;
}
__device__ __forceinline__ bf16x8 pack8(f32x4 a, f32x4 b) {
    u32x4 w = {cvtpk(a[0], a[1]), cvtpk(a[2], a[3]), cvtpk(b[0], b[1]), cvtpk(b[2], b[3])};
    return *reinterpret_cast<bf16x8*>(&w);
}
template <class T> __device__ __forceinline__ bf16x8 load8(const T* p) {
    if constexpr (same_t<T, float>::v) { return pack8(*(const f32x4*)p, *(const f32x4*)(p + 4)); }
    else { return *reinterpret_cast<const bf16x8*>(p); }
}
__device__ __forceinline__ void mask_tile(f32x16& p0, f32x16& p1, int dq, unsigned W) {
    const float NEG = -__builtin_inff();
#pragma unroll
    for (int r = 0; r < 16; ++r) {
        const int c = (r & 3) + 8 * (r >> 2);
        if ((unsigned)(dq - c) >= W) p0[r] = NEG;
        if ((unsigned)(dq - c - 32) >= W) p1[r] = NEG;
    }
}
__device__ __forceinline__ void partialSM(f32x16& p0, f32x16& p1, float& m_reg, float& mn, float& alpha) {
    float pmax = p0[0]; for (int r = 1; r < 16; ++r) pmax = fmaxf(pmax, p0[r]); for (int r = 0; r < 16; ++r) pmax = fmaxf(pmax, p1[r]);
    { auto rr = __builtin_amdgcn_permlane32_swap(__float_as_uint(pmax), __float_as_uint(pmax), false, false);
      pmax = fmaxf(__uint_as_float(rr[0]), __uint_as_float(rr[1])); }
    constexpr float C2 = 1.4426950408889634f * SCALE;
    if (__builtin_expect(__all((pmax - m_reg) * SCALE <= THR), 1)) { mn = m_reg; alpha = 1.f; }
    else { mn = fmaxf(m_reg, pmax); alpha = __builtin_amdgcn_exp2f((m_reg - mn) * C2); m_reg = mn; }
    const float mnL = -mn * C2;
    for (int r = 0; r < 16; ++r) p0[r] = fmaf(p0[r], C2, mnL); for (int r = 0; r < 16; ++r) p1[r] = fmaf(p1[r], C2, mnL);
    for (int r = 0; r < 16; ++r) p0[r] = __builtin_amdgcn_exp2f(p0[r]);
}
__device__ __forceinline__ void finishSM(f32x16& p0, f32x16& p1, float alpha, float& l_reg, bf16x8& pa0, bf16x8& pa1, bf16x8& pa2, bf16x8& pa3) {
    for (int r = 0; r < 16; ++r) p1[r] = __builtin_amdgcn_exp2f(p1[r]);
    float ps = 0; for (int r = 0; r < 16; ++r) ps += p0[r]; for (int r = 0; r < 16; ++r) ps += p1[r];
    { auto rr = __builtin_amdgcn_permlane32_swap(__float_as_uint(ps), __float_as_uint(ps), false, false);
      ps = __uint_as_float(rr[0]) + __uint_as_float(rr[1]); }
    l_reg = l_reg * alpha + ps;
#define PK4(P, B_, OUT) do { unsigned a0 = cvtpk(P[B_+0], P[B_+1]), a1 = cvtpk(P[B_+2], P[B_+3]);                          \
        unsigned b0 = cvtpk(P[B_+4], P[B_+5]), b1 = cvtpk(P[B_+6], P[B_+7]);                                             \
        auto r0 = __builtin_amdgcn_permlane32_swap(a0, b0, false, false); auto r1 = __builtin_amdgcn_permlane32_swap(a1, b1, false, false); \
        u32x4 w = {r0[0], r1[0], r0[1], r1[1]}; OUT = *reinterpret_cast<bf16x8*>(&w); } while (0)
    PK4(p0, 0, pa0); PK4(p0, 8, pa1); PK4(p1, 0, pa2); PK4(p1, 8, pa3);
#undef PK4
}
template <int KB, bool SK>
__device__ __forceinline__ void qkt(f32x16& p0, f32x16& p1, const char* K_lds, int r32, int hi, const bf16x8* qr, bool act, const float* bt) {
    if (SK && !act) { const float NEG = -__builtin_inff();
#pragma unroll
        for (int r = 0; r < 16; ++r) { p0[r] = NEG; p1[r] = NEG; } return; }
    { const f32x4 a0 = *(const f32x4*)(bt), a1 = *(const f32x4*)(bt + 8), a2 = *(const f32x4*)(bt + 16), a3 = *(const f32x4*)(bt + 24);
      const f32x4 c0 = *(const f32x4*)(bt + 32), c1 = *(const f32x4*)(bt + 40), c2 = *(const f32x4*)(bt + 48), c3 = *(const f32x4*)(bt + 56);
      p0 = (f32x16){a0[0], a0[1], a0[2], a0[3], a1[0], a1[1], a1[2], a1[3], a2[0], a2[1], a2[2], a2[3], a3[0], a3[1], a3[2], a3[3]};
      p1 = (f32x16){c0[0], c0[1], c0[2], c0[3], c1[0], c1[1], c1[2], c1[3], c2[0], c2[1], c2[2], c2[3], c3[0], c3[1], c3[2], c3[3]}; }
    const char* kb[4];
#pragma unroll
    for (int dd = 0; dd < 4; ++dd) kb[dd] = K_lds + KB * SHM_K + KSWZ(r32, (dd * 16 + hi * 8) * 2);
#pragma unroll
    for (int d0 = 0; d0 < 8; ++d0) { const char* a = kb[d0 & 3] + (d0 >> 2) * 128;
        bf16x8 b0 = *reinterpret_cast<const bf16x8*>(a);
        bf16x8 b1 = *reinterpret_cast<const bf16x8*>(a + 32 * 256);
        p0 = __builtin_amdgcn_mfma_f32_32x32x16_bf16(b0, qr[d0], p0, 0, 0, 0);
        p1 = __builtin_amdgcn_mfma_f32_32x32x16_bf16(b1, qr[d0], p1, 0, 0, 0); }
}
template <int VB, bool SK>
__device__ __forceinline__ void pv_tile(f32x16* o, int vb0, bf16x8 pa0, bf16x8 pa1, bf16x8 pa2, bf16x8 pa3, bool act) {
    if (SK && !act) return;
#define TRRD(dst, off) asm volatile("ds_read_b64_tr_b16 %0, %1 offset:%2" : "=&v"(dst) : "v"(vb0), "i"(off) : "memory")
#define PV_D0(d0) do { s16x4 l0, l1, l2, l3, h0, h1, h2, h3; constexpr int b_ = VB * SHM_V + v_rd_off(d0, 0, 0);     \
        TRRD(l0, b_); TRRD(h0, b_ + 2048); TRRD(l1, b_ + 4096); TRRD(h1, b_ + 6144); TRRD(l2, b_ + 8192); TRRD(h2, b_ + 10240); TRRD(l3, b_ + 12288); TRRD(h3, b_ + 14336); \
        asm volatile("s_waitcnt lgkmcnt(0)" ::: "memory"); SBAR();                 \
        o[d0] = __builtin_amdgcn_mfma_f32_32x32x16_bf16(pa0, (bf16x8){l0[0], l0[1], l0[2], l0[3], h0[0], h0[1], h0[2], h0[3]}, o[d0], 0, 0, 0);   \
        o[d0] = __builtin_amdgcn_mfma_f32_32x32x16_bf16(pa1, (bf16x8){l1[0], l1[1], l1[2], l1[3], h1[0], h1[1], h1[2], h1[3]}, o[d0], 0, 0, 0);   \
        o[d0] = __builtin_amdgcn_mfma_f32_32x32x16_bf16(pa2, (bf16x8){l2[0], l2[1], l2[2], l2[3], h2[0], h2[1], h2[2], h2[3]}, o[d0], 0, 0, 0);   \
        o[d0] = __builtin_amdgcn_mfma_f32_32x32x16_bf16(pa3, (bf16x8){l3[0], l3[1], l3[2], l3[3], h3[0], h3[1], h3[2], h3[3]}, o[d0], 0, 0, 0); } while (0)
    PV_D0(0); PV_D0(1); PV_D0(2); PV_D0(3);
#undef PV_D0
#undef TRRD
}

template <class TIn, class TOut> struct BlockRef { const TIn* Q; const TIn* K; const TIn* V; TOut* O; int P0; };
template <class TIn> struct Seam {
    bf16x8 qr[8];
    bf16x8 st_v0, st_v1, st_k0, st_k1; f32x4 sf0, sf1, sf2, sf3;
    f32x4 tq[16];
};
__device__ __forceinline__ int swa_jlo(int P0, int W) { const int lowk = P0 - W + 1; return lowk > 0 ? lowk / KVBLK : 0; }
#define ROW(p, k0, rr) ((p) + (size_t)((k0) + (rr)) * LDI + sc)
#define VMW() asm volatile("s_waitcnt vmcnt(0)" ::: "memory")
#define VMWN(n) asm volatile("s_waitcnt vmcnt(%0)" :: "i"(n) : "memory")
#define SLOAD_H(Kp, Vp, k0) do { S.st_v0 = load8<TIn>(ROW(Vp, k0, sr)); S.st_v1 = load8<TIn>(ROW(Vp, k0, 32 + sr));              \
                         S.st_k0 = load8<TIn>(ROW(Kp, k0, sr)); S.st_k1 = load8<TIn>(ROW(Kp, k0, 32 + sr)); } while (0)
#define SWRITE_HK(bf) do { *(bf16x8*)(K_lds + (bf) * SHM_K + kws) = S.st_k0; *(bf16x8*)(K_lds + (bf) * SHM_K + kws + 32 * 256) = S.st_k1; } while (0)
#define SWRITE_HV(bf) do { *(bf16x8*)(V_lds + (bf) * SHM_V + vst0) = S.st_v0; *(bf16x8*)(V_lds + (bf) * SHM_V + vst1) = S.st_v1; } while (0)
#define SWRITE_H(bf) do { SWRITE_HV(bf); SWRITE_HK(bf); } while (0)
#define SLOAD_F(p, k0) do { S.sf0 = *(const f32x4*)ROW(p, k0, sr); S.sf1 = *(const f32x4*)(ROW(p, k0, sr) + 4);                \
                            S.sf2 = *(const f32x4*)ROW(p, k0, 32 + sr); S.sf3 = *(const f32x4*)(ROW(p, k0, 32 + sr) + 4); } while (0)
#define SWRITE_KF(bf) do { *(bf16x8*)(K_lds + (bf) * SHM_K + kws) = pack8(S.sf0, S.sf1); *(bf16x8*)(K_lds + (bf) * SHM_K + kws + 32 * 256) = pack8(S.sf2, S.sf3); } while (0)
#define SWRITE_VF(bf) do { *(bf16x8*)(V_lds + (bf) * SHM_V + vst0) = pack8(S.sf0, S.sf1); *(bf16x8*)(V_lds + (bf) * SHM_V + vst1) = pack8(S.sf2, S.sf3); } while (0)
template <class TIn, class TOut>
__device__ __forceinline__ void causal_swa_prime(const BlockRef<TIn, TOut>& cur, int W, char* lds, Seam<TIn>& S) {
    constexpr bool F32 = same_t<TIn, float>::v;
    const int tid = opaque_tid(), wid = __builtin_amdgcn_readfirstlane(tid >> 6), lane = tid & 63, r32 = lane & 31, hi = lane >> 5;
    const int sr = tid >> 4, sc = (tid & 15) * 8, kws = KSWZ(sr, sc * 2); char* K_lds = lds + 2 * SHM_V;
    const int kb0 = swa_jlo(cur.P0, W) * KVBLK;
    for (int d0 = 0; d0 < 8; ++d0) S.qr[d0] = load8<TIn>(cur.Q + (size_t)(wid * QBLK + r32) * LDI + d0 * 16 + hi * 8);
    if constexpr (F32) { SLOAD_F((const float*)cur.K, kb0); VMW(); SWRITE_KF(0); SBAR(); SLOAD_F((const float*)cur.V, kb0); }
    else { SLOAD_H(cur.K, cur.V, kb0); VMW(); SWRITE_HK(0); }
    __syncthreads();
}
template <class TIn, class TOut>
__device__ __forceinline__ void causal_swa_block(const BlockRef<TIn, TOut>& cur, const BlockRef<TIn, TOut>& nxt, int skv, int W, char* lds, Seam<TIn>& S, const float* bias_l, const float* onorm) {
    constexpr bool F32 = same_t<TIn, float>::v;
    const int tid = opaque_tid(), wid = __builtin_amdgcn_readfirstlane(tid >> 6), lane = tid & 63, r32 = lane & 31, hi = lane >> 5;
    const int j_lo = swa_jlo(cur.P0, W);
    int j_hi = (cur.P0 + QB - 1) / KVBLK + 1; if (j_hi > skv / KVBLK) j_hi = skv / KVBLK;
    const int NT = j_hi - j_lo;
    const int kbn = swa_jlo(nxt.P0, W) * KVBLK;
    const int qlo = cur.P0 + wid * QBLK, qm = qlo + r32 - 4 * hi;
    char* V_lds = lds; char* K_lds = lds + 2 * SHM_V;
    float* ws = (float*)(lds + 2 * SHM_V + 2 * SHM_K) + wid * 64; float* li_l = ws, * al_l = ws + 32;
    float m_reg = -1e30f, l_reg = 0; f32x16 o[4] = {};
    const int sr = tid >> 4, sc = (tid & 15) * 8, vst0 = v_st(sr, sc), vst1 = v_st(32 + sr, sc), kws = KSWZ(sr, sc * 2);
    const int vb0 = (int)(uintptr_t)V_lds + v_rd_base(lane);
    const TIn* Kh = cur.K; const TIn* Vh = cur.V;
#define RESC(a) do { if (__any((a) < 1.f)) { if (hi == 0) al_l[r32] = (a); asm volatile("s_waitcnt lgkmcnt(0)" ::: "memory");              \
                     for (int d_ = 0; d_ < 4; ++d_) for (int r = 0; r < 16; ++r) o[d_][r] *= al_l[crow(r, hi)]; } } while (0)
#define KBASE(t) ((j_lo + (t)) * KVBLK)
#define BT(t) (bias_l + KBASE(t) + 4 * hi)
#define ACT(t) (KBASE(t) <= qlo + QBLK - 1 && KBASE(t) + KVBLK - 1 >= qlo - W + 1)
#define MASKT(P0_, P1_, t) do { const int kb_ = KBASE(t); if ((!SK || ACT(t)) && (kb_ + KVBLK - 1 > qlo || kb_ <= qlo + QBLK - 1 - W)) mask_tile(P0_, P1_, qm - kb_, (unsigned)W); } while (0)
    constexpr int NQL = F32 ? 16 : 8;
    constexpr bool SK = WSKIP && !F32;
#define SEAM_K0() do { VMWN(NQL); if constexpr (F32) { SWRITE_KF(0); SBAR(); SLOAD_F((const float*)nxt.V, kbn); } else { SWRITE_HK(0); } SBAR(); } while (0)
    f32x16 pA0, pA1, pB0, pB1; float mnA, mnB, alA, alB; bf16x8 pa0, pa1, pa2, pa3;
    if constexpr (F32) { VMW(); SWRITE_VF(0); SBAR(); } else { SWRITE_HV(0); SBAR(); }
    if (NT > 1) { if constexpr (F32) SLOAD_F((const float*)Kh, KBASE(1)); else SLOAD_H(Kh, Vh, KBASE(1)); }
    SBAR(); qkt<0, SK>(pA0, pA1, K_lds, r32, hi, S.qr, ACT(0), BT(0));
    if constexpr (F32) { if (NT > 1) { VMW(); SWRITE_KF(1); SBAR(); SLOAD_F((const float*)Vh, KBASE(1)); } }
    MASKT(pA0, pA1, 0); partialSM(pA0, pA1, m_reg, mnA, alA);
    if (NT > 1) { VMW(); if constexpr (F32) { SWRITE_VF(1); SBAR(); if (NT > 2) SLOAD_F((const float*)Kh, KBASE(2)); } else SWRITE_H(1); }
    __syncthreads();
#define HALF_STEP(PX0, PX1, mnX, alX, PY0, PY1, alY, t, KB, VB, SB) do {                                                      \
        SBAR(); qkt<KB, SK>(PX0, PX1, K_lds, r32, hi, S.qr, ACT(t), BT(t));                                             \
        finishSM(PY0, PY1, alY, l_reg, pa0, pa1, pa2, pa3); SBAR();                                                           \
        if ((t) + 1 < NT) { if constexpr (F32) { VMW(); SWRITE_KF(SB); SBAR(); SLOAD_F((const float*)Vh, KBASE((t) + 1)); }  \
                            else { SLOAD_H(Kh, Vh, KBASE((t) + 1)); } SBAR(); }                                               \
        pv_tile<VB, SK>(o, vb0, pa0, pa1, pa2, pa3, ACT((t) - 1)); MASKT(PX0, PX1, (t)); partialSM(PX0, PX1, m_reg, mnX, alX);                                        \
        __syncthreads();                                                                                                      \
        if ((t) + 1 < NT) { VMW(); if constexpr (F32) { SWRITE_VF(SB); SBAR(); if ((t) + 2 < NT) SLOAD_F((const float*)Kh, KBASE((t) + 2)); } \
                            else { SWRITE_H(SB); } }                                                                          \
        RESC(alX); __syncthreads(); } while (0)
    for (int t = 1; t + 1 < NT; t += 2) {
        HALF_STEP(pB0, pB1, mnB, alB, pA0, pA1, alA, t, 1, 0, 0);
        HALF_STEP(pA0, pA1, mnA, alA, pB0, pB1, alB, t + 1, 0, 1, 1);
    }
    const bool even = (NT & 1) == 0;
    if (even) { SBAR(); qkt<1, SK>(pB0, pB1, K_lds, r32, hi, S.qr, ACT(NT - 1), BT(NT - 1)); SBAR(); }
#define QROW(e) (nxt.Q + (size_t)(wid * QBLK + r32) * LDI + ((e) >> 1) * 16 + hi * 8 + ((e) & 1) * 4)
    if constexpr (F32) { SLOAD_F((const float*)nxt.K, kbn); SBAR();
#pragma unroll
        for (int e = 0; e < 8; ++e) S.tq[e] = *(const f32x4*)QROW(e); }
    else { SLOAD_H(nxt.K, nxt.V, kbn); SBAR();
#pragma unroll
        for (int d0 = 0; d0 < 8; ++d0) S.qr[d0] = load8<TIn>(nxt.Q + (size_t)(wid * QBLK + r32) * LDI + d0 * 16 + hi * 8); }
    SBAR();
    finishSM(pA0, pA1, alA, l_reg, pa0, pa1, pa2, pa3); SBAR();
    if constexpr (F32) {
#pragma unroll
        for (int e = 8; e < 16; ++e) S.tq[e] = *(const f32x4*)QROW(e); SBAR(); }
#undef QROW
    pv_tile<0, SK>(o, vb0, pa0, pa1, pa2, pa3, ACT(even ? NT - 2 : NT - 1));
    if (even) { MASKT(pB0, pB1, NT - 1); partialSM(pB0, pB1, m_reg, mnB, alB); __syncthreads(); RESC(alB);
        finishSM(pB0, pB1, alB, l_reg, pa0, pa1, pa2, pa3); SBAR(); pv_tile<1, SK>(o, vb0, pa0, pa1, pa2, pa3, ACT(NT - 1)); }
    SBAR(); SEAM_K0();
    if (hi == 0) li_l[r32] = l_reg; asm volatile("s_waitcnt lgkmcnt(0)" ::: "memory");
    float rli[16];
#pragma unroll
    for (int r = 0; r < 16; ++r) rli[r] = __builtin_amdgcn_rcpf(li_l[crow(r, hi)]);
    TOut* Ow = cur.O + (size_t)(wid * QBLK) * LDO;
#pragma unroll
    for (int r = 0; r < 16; ++r) { const int orow = crow(r, hi);
        float v4[4]; float ss = 0.f;
#pragma unroll
        for (int d0 = 0; d0 < 4; ++d0) { v4[d0] = o[d0][r] * rli[r]; ss += v4[d0] * v4[d0]; }
        ss += __shfl_xor(ss, 1); ss += __shfl_xor(ss, 2); ss += __shfl_xor(ss, 4); ss += __shfl_xor(ss, 8); ss += __shfl_xor(ss, 16);
        const float rn = __builtin_amdgcn_rsqf(ss * (1.f / 128.f) + 1e-6f);
#pragma unroll
        for (int d0 = 0; d0 < 4; ++d0) { const float v = v4[d0] * rn * onorm[d0 * 32 + r32];
            const float vn = __shfl_xor(v, 1);
            if ((r32 & 1) == 0) *(unsigned*)(Ow + (size_t)orow * LDO + d0 * 32 + r32) = cvtpk(v, vn); } }
    if constexpr (F32) {
#pragma unroll
        for (int d0 = 0; d0 < 8; ++d0) S.qr[d0] = pack8(S.tq[2 * d0], S.tq[2 * d0 + 1]); }
    __syncthreads();
#undef RESC
#undef KBASE
#undef BT
#undef ACT
#undef MASKT
#undef SEAM_K0
#undef HALF_STEP
}
#undef ROW
#undef VMW
}
__device__ __forceinline__ fa::BlockRef<bf16_t, bf16_t> fox_ref(int Li, int pass, const bf16_t* QKV, bf16_t* O) {
    using namespace fa;
    BlockRef<bf16_t, bf16_t> r; const int xcd = Li & 7, k = Li >> 3, bh = (k >> 4) * 8 + xcd, x = k & 15, qb = pass ? 31 - x : x, b = bh >> 3, h = bh & 7;
    r.Q = QKV + ((size_t)((0 * NB + b) * NHD + h) * SEQ + qb * QB) * 128; r.K = QKV + ((size_t)((1 * NB + b) * NHD + h) * SEQ) * 128; r.V = QKV + ((size_t)((2 * NB + b) * NHD + h) * SEQ) * 128;
    r.O = O + ((size_t)(b * SEQ + qb * QB)) * LDO + h * 128; r.P0 = qb * QB; return r;
}
__device__ __forceinline__ void phase_attn(const bf16_t* __restrict__ QKV, bf16_t* __restrict__ O, const float* __restrict__ BIAS, const float* __restrict__ onorm, char* lds) {
    using namespace fa;
    float* bias_l = (float*)(lds + LDS_BYTES);
    constexpr int total = 512;
    int L = blockIdx.x; if (L >= total) return;
    const int stride = gridDim.x, tid = opaque_tid();
    int pass = 0, loaded = -1; int Wr; asm volatile("s_mov_b32 %0, 8192" : "=s"(Wr));
    BlockRef<bf16_t, bf16_t> cur = fox_ref(L, 0, QKV, O);
    Seam<bf16_t> S;
    causal_swa_prime<bf16_t, bf16_t>(cur, Wr, lds, S);
    for (;;) {
        const bool more_pass = pass == 0, more_item = L + stride < total, last = !more_pass && !more_item;
        int passn = pass + 1, Ln = L;
        if (!more_pass) { passn = 0; Ln = more_item ? L + stride : L; }
        const BlockRef<bf16_t, bf16_t> nxt = last ? cur : fox_ref(Ln, passn, QKV, O);
        const int bh = ((L >> 3) >> 4) * 8 + (L & 7);
        if (bh != loaded) { const float* src = BIAS + (size_t)bh * SEQ + tid * 4;
            const int wq = __builtin_amdgcn_readfirstlane(tid >> 6);
#pragma unroll
            for (int i = 0; i < 4; ++i) __builtin_amdgcn_global_load_lds((const unsigned*)(src + i * 2048), (PG8_LAS unsigned*)(bias_l + i * 2048 + wq * 256), 16, 0, 0);
            asm volatile("s_waitcnt vmcnt(0)" ::: "memory");
            loaded = bh; __syncthreads(); }
        causal_swa_block<bf16_t, bf16_t>(cur, nxt, SEQ, Wr, lds, S, bias_l, onorm);
        if (last) break;
        cur = nxt; pass = passn; L = Ln;
    }
}

#ifndef PH_MASK
#define PH_MASK 0xFFFF
#endif
#define PH(b) if constexpr ((PH_MASK >> (b)) & 1)
#ifndef DUP_MASK
#define DUP_MASK 0
#endif
#define DUP(b) if constexpr ((DUP_MASK >> (b)) & 1)
__global__ void __launch_bounds__(512, 2) fwd_megakernel(Params p) {
    extern __shared__ __attribute__((aligned(16))) unsigned char shm[];
    cg::grid_group grid = cg::this_grid();
    PG8_LAS unsigned char* glds = (PG8_LAS unsigned char*)shm;
    float* tile = (float*)shm;
    pg8::StaticOrder S;
    DUP(0) { phase_prologue(p, shm); grid.sync(); }
    DUP(11) { float* cond = (float*)shm; for (int i = opaque_tid(); i < 8192; i += 512) { const float c = p.c[i]; cond[i] = c / (1.f + __expf(-c)); } __syncthreads(); for (int t = blockIdx.x; t < 288; t += gridDim.x) mod_task(p, t, cond, cond + 8192); grid.sync(); }
    DUP(12) { conv_run<0>(p, CT_GU + CT_D + CT_IN + CT_OUT, tile); grid.sync(); }
    PH(0) phase_prologue(p, shm);
    grid.sync();
#define FFN_BLOCK(f) do { const float* xin = (f) ? p.out : p.x; \
        PH(1) phase_norm(xin, p.norm_g + ((f) ? 2 : 0) * DM, p.MOD_(), (f) ? 6 : 0, (f) ? 7 : 1, p.H_()); \
        grid.sync(); \
        PH(2) { pg8::Gemm g{p.H_(), p.WGU_(), MTOK, 2 * DFF, DM}; S.init(g.M, g.N, (int)gridDim.x, (int)blockIdx.x); EpiSwiGLU E{p.HID_()}; \
          pg8::gemm_phase<EpiSwiGLU, pg8::StaticOrder, false>(glds, g, S, E, nullptr); } \
        grid.sync(); \
        PH(3) { pg8::Gemm g{p.HID_(), p.WD_(), MTOK, DM, DFF}; S.init(g.M, g.N, (int)gridDim.x, (int)blockIdx.x); EpiResid E{xin, p.out, p.MOD_() + ((f) ? 8 : 2) * DM, 0.5f}; \
          pg8::gemm_phase<EpiResid, pg8::StaticOrder, false>(glds, g, S, E, nullptr); } \
        grid.sync(); } while (0)
    DUP(2) { pg8::Gemm g{p.H_(), p.WGU_(), MTOK, 2 * DFF, DM}; S.init(g.M, g.N, (int)gridDim.x, (int)blockIdx.x); EpiSwiGLU E{p.HID_()}; phase_norm(p.x, p.norm_g, p.MOD_(), 0, 1, p.H_()); grid.sync(); pg8::gemm_phase<EpiSwiGLU, pg8::StaticOrder, false>(glds, g, S, E, nullptr); grid.sync(); }
    FFN_BLOCK(0);
    PH(1) phase_norm(p.out, p.norm_g + DM, p.MOD_(), 3, 4, p.H_());
    grid.sync();
    PH(4) { pg8::Gemm g{p.H_(), p.WIN_(), MTOK, NPROJ, DM}; S.init(g.M, g.N, (int)gridDim.x, (int)blockIdx.x); EpiProj E{p.QKVF_(), p.QKVG_(), p.Z_(), p.SMALL_()};
      pg8::gemm_phase<EpiProj, pg8::StaticOrder, false>(glds, g, S, E, nullptr); }
    grid.sync();
    DUP(5) { for (int t = blockIdx.x; t < 32 + NTASK; t += gridDim.x) { if (t < 32) cumsum_task(p, t, (float*)shm); else g1_task(p, t - 32, shm); } grid.sync(); }
    PH(5) for (int t = blockIdx.x; t < 32 + NTASK; t += gridDim.x) { if (t < 32) cumsum_task(p, t, (float*)shm); else g1_task(p, t - 32, shm); }
    grid.sync();
    DUP(6) { phase_g2(p, shm); grid.sync(); }
    DUP(7) { phase_attn(p.QKVF_(), p.H_(), p.BIAS_(), p.fox_out_norm, (char*)shm); grid.sync(); }
    PH(6) phase_g2(p, shm);
    PH(7) phase_attn(p.QKVF_(), p.H_(), p.BIAS_(), p.fox_out_norm, (char*)shm);
    grid.sync();
    PH(8) phase_gdn_out(p);
    PH(8) conv_run<1>(p, CT_GU + CT_D, tile);
    grid.sync();
    PH(9) { pg8::Gemm g{p.H_(), p.WOUT_(), MTOK, DM, DM}; S.init(g.M, g.N, (int)gridDim.x, (int)blockIdx.x); EpiResid E{p.out, p.out, p.MOD_() + 5 * DM, 1.0f};
      pg8::gemm_phase<EpiResid, pg8::StaticOrder, false>(glds, g, S, E, nullptr); }
    grid.sync();
    FFN_BLOCK(1);
    PH(10) phase_final_norm(p.out, p.final_norm);
}

extern "C" void kernel_launch(void* const* d_in, const int* in_sizes, int n_in, void* d_out, int out_size, void* d_ws, size_t ws_size, hipStream_t stream) {
    static int grid_blocks = 0;
    if (grid_blocks == 0) {
        if (n_in != 17 || out_size != MTOK * DM || ws_size < O_END) { fprintf(stderr, "kernel_launch: unexpected shapes (n_in %d out %d ws %zu need %zu)\n", n_in, out_size, ws_size, (size_t)O_END); grid_blocks = -1; return; }
        int dev = 0, cus = 0, per_cu = 0;
        hipGetDevice(&dev); hipDeviceGetAttribute(&cus, hipDeviceAttributeMultiprocessorCount, dev);
        if (hipFuncSetAttribute((const void*)fwd_megakernel, hipFuncAttributeMaxDynamicSharedMemorySize, LDS_TOTAL) != hipSuccess) { fprintf(stderr, "kernel_launch: hipFuncSetAttribute failed\n"); grid_blocks = -1; return; }
        if (hipOccupancyMaxActiveBlocksPerMultiprocessor(&per_cu, (const void*)fwd_megakernel, 512, LDS_TOTAL) != hipSuccess || per_cu < 1) { fprintf(stderr, "kernel_launch: occupancy query failed (%d)\n", per_cu); per_cu = 1; }
        (void)hipGetLastError();
        grid_blocks = cus * per_cu;
    }
    if (grid_blocks < 0) return;
    Params p{};
    const float** in = (const float**)&p;
    for (int i = 0; i < 17; ++i) in[i] = (const float*)d_in[i];
    unsigned char* ws = (unsigned char*)d_ws;
    p.out = (float*)d_out;
    p.ws = ws;
    void* args[] = {&p};
    hipError_t e = hipLaunchCooperativeKernel((const void*)fwd_megakernel, dim3(grid_blocks), dim3(512), args, LDS_TOTAL, stream);
    if (e != hipSuccess) fprintf(stderr, "cooperative launch failed: %s (grid %d)\n", hipGetErrorString(e), grid_blocks);
}
```

```cpp
#include <hip/hip_runtime.h>
#include <hip/hip_bf16.h>
#include <hip/hip_cooperative_groups.h>
#include <cstdio>
#include <cstdint>
namespace cg = cooperative_groups;

constexpr int MTOK = 32768, DM = 2048, DFF = 5632, SEQ = 8192, NB = 4, NHD = 8, HD = 128, NMOD = 18432;
constexpr int NPROJ = 7424;
constexpr int NCHUNK = 128, CH = 64, NTASK = NB * NHD * NCHUNK;
constexpr size_t G1_UT = 0, G1_W = 16384, G1_QG = 32768, G1_KDT = 49152, G1_AQ = 65536, G1_BYTES = 73728;
constexpr int LDS_TOTAL = 151552;
__device__ __forceinline__ int opaque_tid() { int t; asm volatile("v_mov_b32 %0, %1" : "=v"(t) : "v"(threadIdx.x)); return t; }
namespace pg8 {
#define PG8_LAS __attribute__((address_space(3)))
typedef unsigned short bf16_t;
typedef short bf16x8 __attribute__((ext_vector_type(8)));
typedef float f32x4 __attribute__((ext_vector_type(4)));
typedef unsigned u32x4 __attribute__((ext_vector_type(4)));
constexpr int BM = 256, BK = 64, HALF = 128, HTB = HALF * BK * 2  , STAGE_BYTES = 8 * HTB, NXCD = 8, WGM = 8;

__host__ __device__ __forceinline__ int lds_byte(int r, int c) { const int st = (r >> 4) * 2 + (c >> 5), rr = r & 15, cc = c & 31, ob = rr * 64 + cc * 2; return st * 1024 + (ob ^ (((ob >> 9) & 1) << 5)); }
__host__ __device__ __forceinline__ void stage_rc(int b, int& R, int& C) { const int st = b / 1024, sb = b % 1024, swz = sb ^ (((sb >> 9) & 1) << 5); R = (st >> 1) * 16 + swz / 64; C = (st & 1) * 32 + (swz % 64) / 2; }
__host__ __device__ __forceinline__ int perm32(int rho) { const int n = rho >> 4, i = rho & 15; return 8 * (i >> 2) + 4 * n + (i & 3); }

struct Unit { int pm, pn; };
struct Gemm { const bf16_t* A; const bf16_t* Bt; int M, N, K; };

struct StaticOrder {
    int nM, nN, nwg, G, c;
    __host__ __device__ void init(int M, int N, int G_, int c_) { nM = M / BM; nN = N / BM; nwg = nM * nN; G = G_; c = c_; }
    __host__ __device__ bool next(int i, Unit& u) const {
        const long L = (long)i * G + c; if (L >= nwg) return false;
        int wgid = (int)L; { const int q = nwg / NXCD, r = nwg % NXCD, xcd = wgid % NXCD, off = wgid / NXCD; wgid = (xcd < r ? xcd * (q + 1) : r * (q + 1) + (xcd - r) * q) + off; }
        const int nig = WGM * nN, gid = wgid / nig, fm = gid * WGM, gsz = (nM - fm) < WGM ? (nM - fm) : WGM;
        u.pm = fm + ((wgid % nig) % gsz); u.pn = (wgid % nig) / gsz; return true;
    }
    __device__ __forceinline__ void a_ready(const Unit&) const {}
    __device__ __forceinline__ void done(const Unit&) const {}
};
template <class Epi, class Sched, bool STAMP = false>
__device__ __forceinline__ void gemm_phase(PG8_LAS unsigned char* lds, const Gemm g, const Sched& S, const Epi& E, unsigned long long* stamps) {
    const int tid = opaque_tid(), wid = __builtin_amdgcn_readfirstlane(tid >> 6), lane = tid & 63, wr = wid >> 2, wc = wid & 3, fr = lane & 15, fq = lane >> 4;
    const int K = g.K, nt = K / BK;
    int ts_lo = 0, ts_hi = 0, nts = 0; const unsigned long long rt_entry = STAMP ? (unsigned long long)wall_clock64() : 0ull;
#define PG8_STAMP() do { if (STAMP && wid == 0 && nts < 64) { const unsigned long long _c = (unsigned long long)clock64(); \
        ts_lo = (lane == nts) ? (int)(unsigned)_c : ts_lo; ts_hi = (lane == nts) ? (int)(unsigned)(_c >> 32) : ts_hi; ++nts; } } while (0)
    PG8_STAMP();
    unsigned voffA[2], voffB[2];
#pragma unroll
    for (int i = 0; i < 2; ++i) { int R, C; stage_rc(tid * 16 + i * 8192, R, C); const int Rb = Epi::PERM ? ((R & ~31) + perm32(R & 31)) : R;
        voffA[i] = (unsigned)(R * K + C) * 2u; voffB[i] = (unsigned)(Rb * K + C) * 2u; }
    const size_t kstep = (size_t)(BK * 2);
    const size_t hstep = (size_t)HALF * K * 2;
    const size_t tstep = 2 * hstep;
    const unsigned ldsw = (unsigned)wid * 1024u;
    const int aoff = lds_byte(wr * 64 + fr, fq * 8), boff = lds_byte(wc * 32 + fr, fq * 8);
#define PG8_SA(b, h) (((b) * 2 + (h)) * HTB)
#define PG8_SB(b, h) ((4 + (b) * 2 + (h)) * HTB)
#define PG8_STAGE(bufoff, gbase, voff) do { _Pragma("unroll") for (int _i = 0; _i < 2; ++_i) \
        __builtin_amdgcn_global_load_lds((const unsigned*)((const char*)(gbase) + (voff)[_i]), (PG8_LAS unsigned*)(lds + (bufoff) + ldsw + _i * 8192), 16, 0, 0); } while (0)
#define PG8_LDA(dst, b, h) do { _Pragma("unroll") for (int m = 0; m < 4; ++m) _Pragma("unroll") for (int k = 0; k < 2; ++k) dst[m][k] = *(const PG8_LAS bf16x8*)(lds + PG8_SA(b, h) + aoff + m * 2048 + k * 1024); } while (0)
#define PG8_LDB(dst, b, h) do { _Pragma("unroll") for (int n = 0; n < 2; ++n) _Pragma("unroll") for (int k = 0; k < 2; ++k) dst[n][k] = *(const PG8_LAS bf16x8*)(lds + PG8_SB(b, h) + boff + n * 2048 + k * 1024); } while (0)
#define PG8_MMA(ai, bj, At, Bt) do { __builtin_amdgcn_s_setprio(1); _Pragma("unroll") for (int m = 0; m < 4; ++m) _Pragma("unroll") for (int n = 0; n < 2; ++n) _Pragma("unroll") for (int k = 0; k < 2; ++k) \
        acc[ai][bj][m][n] = __builtin_amdgcn_mfma_f32_16x16x32_bf16(Bt[n][k], At[m][k], acc[ai][bj][m][n], 0, 0, 0); __builtin_amdgcn_s_setprio(0); } while (0)
#define PG8_WAIT_V(n) asm volatile("s_waitcnt vmcnt(" #n ")" ::: "memory")
#define PG8_WAIT_L(n) asm volatile("s_waitcnt lgkmcnt(" #n ")" ::: "memory")
#define PG8_BAR __builtin_amdgcn_s_barrier()
#define PG8_SCHED __builtin_amdgcn_sched_barrier(0)
    Unit cur, nxt; int ui = 0;
    if (!S.next(0, cur)) return;
    f32x4 acc[2][2][4][2];
#pragma unroll
    for (int a = 0; a < 2; ++a)
#pragma unroll
        for (int b = 0; b < 2; ++b)
#pragma unroll
            for (int m = 0; m < 4; ++m)
#pragma unroll
                for (int n = 0; n < 2; ++n) acc[a][b][m][n] = (f32x4){0.f, 0.f, 0.f, 0.f};
    bf16x8 At[4][2], B0[2][2], B1[2][2];
    const char* cA = (const char*)g.A + (size_t)cur.pm * tstep; const char* cB = (const char*)g.Bt + (size_t)cur.pn * tstep;
    S.a_ready(cur);
    PG8_STAGE(PG8_SB(0, 0), cB, voffB); PG8_STAGE(PG8_SA(0, 0), cA, voffA); PG8_STAGE(PG8_SB(0, 1), cB + hstep, voffB); PG8_STAGE(PG8_SA(0, 1), cA + hstep, voffA);
    if (wr == 1) PG8_BAR;
    PG8_WAIT_V(4); PG8_BAR;
    PG8_STAGE(PG8_SB(1, 0), cB + kstep, voffB); PG8_STAGE(PG8_SA(1, 0), cA + kstep, voffA); PG8_STAGE(PG8_SB(1, 1), cB + hstep + kstep, voffB);
    PG8_WAIT_V(6); PG8_BAR;
    PG8_STAMP();
    for (;;) {
        const bool has_next = S.next(ui + 1, nxt);
        const char* nA = has_next ? (const char*)g.A + (size_t)nxt.pm * tstep : cA; const char* nB = has_next ? (const char*)g.Bt + (size_t)nxt.pn * tstep : cB;
        for (int t = 0; t < nt; t += 2) {
            const bool last = (t == nt - 2);
            const char* a1 = cA + (size_t)(t + 1) * kstep;
            const char* a2 = last ? nA : cA + (size_t)(t + 2) * kstep; const char* b2 = last ? nB : cB + (size_t)(t + 2) * kstep;
            const char* a3 = a2 + kstep; const char* b3 = b2 + kstep;
            if (last && has_next) S.a_ready(nxt);
            PG8_LDB(B0, 0, 0); PG8_SCHED; PG8_LDA(At, 0, 0); PG8_STAGE(PG8_SA(1, 1), a1 + hstep, voffA);
            PG8_WAIT_L(8); PG8_BAR; PG8_WAIT_L(0); PG8_MMA(0, 0, At, B0); PG8_BAR; PG8_SCHED;
            PG8_LDB(B1, 0, 1); PG8_STAGE(PG8_SB(0, 0), b2, voffB);
            PG8_BAR; PG8_WAIT_L(0); PG8_MMA(0, 1, At, B1); PG8_BAR;
            PG8_LDA(At, 0, 1); PG8_STAGE(PG8_SA(0, 0), a2, voffA);
            PG8_BAR; PG8_WAIT_L(0); PG8_MMA(1, 0, At, B0); PG8_BAR; PG8_SCHED;
            PG8_STAGE(PG8_SB(0, 1), b2 + hstep, voffB);
            PG8_WAIT_V(6); PG8_BAR; PG8_MMA(1, 1, At, B1); PG8_BAR;
            PG8_LDB(B0, 1, 0); PG8_SCHED; PG8_LDA(At, 1, 0); PG8_STAGE(PG8_SA(0, 1), a2 + hstep, voffA);
            PG8_WAIT_L(8); PG8_BAR; PG8_WAIT_L(0); PG8_MMA(0, 0, At, B0); PG8_BAR; PG8_SCHED;
            PG8_LDB(B1, 1, 1); PG8_STAGE(PG8_SB(1, 0), b3, voffB);
            PG8_BAR; PG8_WAIT_L(0); PG8_MMA(0, 1, At, B1); PG8_BAR;
            PG8_LDA(At, 1, 1); PG8_STAGE(PG8_SA(1, 0), a3, voffA);
            PG8_BAR; PG8_WAIT_L(0); PG8_MMA(1, 0, At, B0); PG8_BAR; PG8_SCHED;
            PG8_STAGE(PG8_SB(1, 1), b3 + hstep, voffB);
            PG8_WAIT_V(6); PG8_BAR; PG8_MMA(1, 1, At, B1); PG8_BAR;
        }
        PG8_STAMP();
        if constexpr (!Epi::AFTER_DRAIN) { E(acc, cur, wr, wc, fr, fq); S.done(cur); }
        PG8_STAMP();
        if (!has_next) break;
#pragma unroll
        for (int a = 0; a < 2; ++a)
#pragma unroll
            for (int b = 0; b < 2; ++b)
#pragma unroll
                for (int m = 0; m < 4; ++m)
#pragma unroll
                    for (int n = 0; n < 2; ++n) acc[a][b][m][n] = (f32x4){0.f, 0.f, 0.f, 0.f};
        cur = nxt; cA = nA; cB = nB; ++ui;
    }
    PG8_WAIT_V(0);
    if (wr == 0) PG8_BAR;
    PG8_BAR;
    if constexpr (Epi::AFTER_DRAIN) { E.fused(acc, cur, wr, wc, fr, fq, lds, wid, lane); S.done(cur); }
    PG8_STAMP();
    if (STAMP && wid == 0) { stamps[lane] = lane < nts ? (((unsigned long long)(unsigned)ts_hi << 32) | (unsigned)ts_lo) : 0ull;
        if (lane == 62) stamps[62] = rt_entry; if (lane == 63) stamps[63] = (unsigned long long)wall_clock64(); }
#undef PG8_STAMP
#undef PG8_SA
#undef PG8_SB
#undef PG8_STAGE
#undef PG8_LDA
#undef PG8_LDB
#undef PG8_MMA
#undef PG8_WAIT_V
#undef PG8_WAIT_L
#undef PG8_BAR
#undef PG8_SCHED
}
}
using pg8::bf16_t; using pg8::bf16x8; using pg8::f32x4; using pg8::u32x4; using pg8::Unit;
typedef unsigned u32x2 __attribute__((ext_vector_type(2)));

constexpr size_t O_WGU = 0, O_WD = O_WGU + (size_t)2 * DFF * DM * 2, O_WIN = O_WD + (size_t)DM * DFF * 2, O_WOUT = O_WIN + (size_t)NPROJ * DM * 2,
    O_MOD = O_WOUT + (size_t)DM * DM * 2, O_H = O_MOD + (size_t)NB * NMOD * 4, O_QKVF = O_H + (size_t)MTOK * DM * 2, O_QKVG = O_QKVF + (size_t)MTOK * 3072 * 2,
    O_Z = O_QKVG + (size_t)MTOK * 3072 * 2, O_SMALL = O_Z + (size_t)MTOK * 1024 * 2, O_BIAS = O_SMALL + (size_t)MTOK * 32 * 4, O_GL = O_BIAS + (size_t)32 * SEQ * 4,
    O_G1 = O_GL + (size_t)NTASK * 4, O_ROWSS = O_G1 + (size_t)NTASK * G1_BYTES, O_CB1 = O_ROWSS + (size_t)2 * MTOK * 4, O_CB2 = O_CB1 + (size_t)NB * NPROJ * 4,
    O_END = O_CB2 + (size_t)NB * 2 * DFF * 4, O_HID = O_QKVF, O_OG = O_QKVG, O_HB2 = O_G1;
struct Params {
    const float *x, *c, *ada_w, *ada_b, *norm_g, *wg, *wu, *wd, *w_in, *w_out, *fox_f_bias, *fox_out_norm, *gdn_conv, *gdn_A_log, *gdn_dt_bias, *gdn_out_norm, *final_norm;
    float* out;
    unsigned char* ws;
    __device__ __forceinline__ bf16_t* WGU_() const { return (bf16_t*)(ws + O_WGU); }
    __device__ __forceinline__ bf16_t* WD_() const { return (bf16_t*)(ws + O_WD); }
    __device__ __forceinline__ bf16_t* WIN_() const { return (bf16_t*)(ws + O_WIN); }
    __device__ __forceinline__ bf16_t* WOUT_() const { return (bf16_t*)(ws + O_WOUT); }
    __device__ __forceinline__ bf16_t* H_() const { return (bf16_t*)(ws + O_H); }
    __device__ __forceinline__ bf16_t* QKVF_() const { return (bf16_t*)(ws + O_QKVF); }
    __device__ __forceinline__ bf16_t* QKVG_() const { return (bf16_t*)(ws + O_QKVG); }
    __device__ __forceinline__ bf16_t* Z_() const { return (bf16_t*)(ws + O_Z); }
    __device__ __forceinline__ bf16_t* HID_() const { return (bf16_t*)(ws + O_HID); }
    __device__ __forceinline__ float* MOD_() const { return (float*)(ws + O_MOD); }
    __device__ __forceinline__ float* SMALL_() const { return (float*)(ws + O_SMALL); }
    __device__ __forceinline__ float* BIAS_() const { return (float*)(ws + O_BIAS); }
    __device__ __forceinline__ float* GL_() const { return (float*)(ws + O_GL); }
    __device__ __forceinline__ float* OG_() const { return (float*)(ws + O_OG); }
    __device__ __forceinline__ unsigned char* G1OUT_() const { return ws + O_G1; }
    __device__ __forceinline__ bf16_t* HB2_() const { return (bf16_t*)(ws + O_HB2); }
    __device__ __forceinline__ float* ROWSS_() const { return (float*)(ws + O_ROWSS); }
    __device__ __forceinline__ float* CB1_() const { return (float*)(ws + O_CB1); }
    __device__ __forceinline__ float* CB2_() const { return (float*)(ws + O_CB2); }
};

__device__ __forceinline__ unsigned cvtpk(float lo, float hi) { unsigned r; asm volatile("v_cvt_pk_bf16_f32 %0, %1, %2" : "=v"(r) : "v"(lo), "v"(hi)); return r; }
__device__ __forceinline__ float bf2f(unsigned short b) { return __uint_as_float(((unsigned)b) << 16); }
__device__ __forceinline__ float bflo(unsigned w) { return __uint_as_float(w << 16); }
__device__ __forceinline__ float bfhi(unsigned w) { return __uint_as_float(w & 0xffff0000u); }
__device__ __forceinline__ float wave_sum(float v) { for (int o = 32; o; o >>= 1) v += __shfl_xor(v, o); return v; }
__device__ __forceinline__ float silu_f(float v) { return v * __builtin_amdgcn_rcpf(1.f + __expf(-v)); }
__device__ __forceinline__ float softplus_f(float v) { return fmaxf(v, 0.f) + log1pf(__expf(-fabsf(v))); }

template <bool FUSED> struct EpiSwiGLU { static constexpr bool PERM = true, AFTER_DRAIN = false; const Params& p;
    __device__ __forceinline__ void operator()(const f32x4 (&acc)[2][2][4][2], const Unit& u, int wr, int wc, int fr, int fq) const {
        const int row0 = u.pm * 256 + wr * 64 + fr, col0 = u.pn * 128 + wc * 32 + 8 * fq, b = u.pm >> 5;
        bf16_t* O = p.HID_(); const float* rowss = p.ROWSS_() + MTOK; const float* cb = p.CB2_();
        f32x4 cbv[2][2];
        if (FUSED) {
#pragma unroll
            for (int bj = 0; bj < 2; ++bj)
#pragma unroll
                for (int n = 0; n < 2; ++n) cbv[bj][n] = *(const f32x4*)(cb + (size_t)b * (2 * DFF) + u.pn * 256 + bj * 128 + wc * 32 + 8 * fq + 4 * n);
        }
#pragma unroll
        for (int ai = 0; ai < 2; ++ai)
#pragma unroll
            for (int m = 0; m < 4; ++m) { const int row = row0 + ai * 128 + m * 16; bf16_t* rowp = O + (size_t)row * DFF + col0;
                float rr = 1.f; if (FUSED) rr = __builtin_amdgcn_rsqf(rowss[row] * (1.f / DM) + 1e-6f);
                float h[8];
#pragma unroll
                for (int n = 0; n < 2; ++n)
#pragma unroll
                    for (int j = 0; j < 4; ++j) { float g = acc[ai][0][m][n][j], up = acc[ai][1][m][n][j];
                        if (FUSED) { g = rr * g + cbv[0][n][j]; up = rr * up + cbv[1][n][j]; }
                        h[n * 4 + j] = silu_f(g) * up; }
                *(u32x4*)rowp = (u32x4){cvtpk(h[0], h[1]), cvtpk(h[2], h[3]), cvtpk(h[4], h[5]), cvtpk(h[6], h[7])}; }
    }
};
template <int VAR> struct EpiResid { static constexpr bool PERM = false, AFTER_DRAIN = false, FUSE = VAR < 2; const Params& p;
    __device__ __forceinline__ void operator()(const f32x4 (&acc)[2][2][4][2], const Unit& u, int wr, int wc, int fr, int fq) const {
        const float* xin = VAR == 0 ? p.x : p.out; float* out = p.out; const float* gate = p.MOD_() + (VAR == 0 ? 2 : VAR == 1 ? 5 : 8) * DM; const float s = VAR == 1 ? 1.0f : 0.5f;
        bf16_t* hb = VAR == 0 ? p.H_() : p.HB2_(); const float* gn = p.norm_g + (VAR + 1) * DM; const float* sc = p.MOD_() + (VAR == 0 ? 4 : 7) * DM; float* rowss = p.ROWSS_() + VAR * MTOK;
        const int row0 = u.pm * 256 + wr * 64 + fr, col0 = u.pn * 256 + wc * 32 + 4 * fq, b = u.pm >> 5;
        f32x4 gv[2][2], gG[2][2];
#pragma unroll
        for (int bj = 0; bj < 2; ++bj)
#pragma unroll
            for (int n = 0; n < 2; ++n) { gv[bj][n] = *(const f32x4*)(gate + (size_t)b * NMOD + col0 + bj * 128 + n * 16) * s;
                if (FUSE) gG[bj][n] = *(const f32x4*)(gn + col0 + bj * 128 + n * 16) * (*(const f32x4*)(sc + (size_t)b * NMOD + col0 + bj * 128 + n * 16) + 1.f); }
#pragma unroll
        for (int ai = 0; ai < 2; ++ai)
#pragma unroll
            for (int m = 0; m < 4; ++m) { const int row = row0 + ai * 128 + m * 16; const size_t ro = (size_t)row * DM + col0; float ss = 0.f;
#pragma unroll
                for (int bj = 0; bj < 2; ++bj)
#pragma unroll
                    for (int n = 0; n < 2; ++n) { const f32x4 xv = *(const f32x4*)(xin + ro + bj * 128 + n * 16);
                        const f32x4 xn = xv + gv[bj][n] * acc[ai][bj][m][n];
                        *(f32x4*)(out + ro + bj * 128 + n * 16) = xn;
                        if (FUSE) { const f32x4 hv = xn * gG[bj][n]; ss += xn[0] * xn[0] + xn[1] * xn[1] + xn[2] * xn[2] + xn[3] * xn[3];
                            *(u32x2*)(hb + ro + bj * 128 + n * 16) = (u32x2){cvtpk(hv[0], hv[1]), cvtpk(hv[2], hv[3])}; } }
                if (FUSE) { ss += __shfl_xor(ss, 16); ss += __shfl_xor(ss, 32); if (fq == 0) (void)__hip_atomic_fetch_add(rowss + row, ss, __ATOMIC_RELAXED, __HIP_MEMORY_SCOPE_AGENT); } }
    }
};
struct EpiProj { static constexpr bool PERM = true, AFTER_DRAIN = false; const Params& p;
    __device__ __forceinline__ void operator()(const f32x4 (&acc0)[2][2][4][2], const Unit& u, int wr, int wc, int fr, int fq) const {
        bf16_t* qkvf = p.QKVF_(); bf16_t* qkvg = p.QKVG_(); bf16_t* z = p.Z_(); float* small = p.SMALL_(); const float* rowss = p.ROWSS_(); const float* cb = p.CB1_();
        const int row0 = u.pm * 256 + wr * 64 + fr;
        f32x4 acc[2][2][4][2];
        { const int bb = u.pm >> 5; f32x4 cbv[2][2];
#pragma unroll
          for (int bj = 0; bj < 2; ++bj)
#pragma unroll
              for (int n = 0; n < 2; ++n) cbv[bj][n] = *(const f32x4*)(cb + (size_t)bb * NPROJ + u.pn * 256 + bj * 128 + wc * 32 + 8 * fq + 4 * n);
#pragma unroll
          for (int ai = 0; ai < 2; ++ai)
#pragma unroll
              for (int m = 0; m < 4; ++m) { const float rr = __builtin_amdgcn_rsqf(rowss[row0 + ai * 128 + m * 16] * (1.f / DM) + 1e-6f);
#pragma unroll
                  for (int bj = 0; bj < 2; ++bj)
#pragma unroll
                      for (int n = 0; n < 2; ++n) acc[ai][bj][m][n] = acc0[ai][bj][m][n] * rr + cbv[bj][n]; } }
        if (u.pn == 28) {
            if (wc == 0) {
#pragma unroll
                for (int ai = 0; ai < 2; ++ai)
#pragma unroll
                    for (int m = 0; m < 4; ++m) { float* rp = small + (size_t)(row0 + ai * 128 + m * 16) * 32 + 8 * fq;
                        *(f32x4*)rp = acc[ai][0][m][0]; *(f32x4*)(rp + 4) = acc[ai][0][m][1]; }
            }
            return;
        }
        if (u.pn < 12) {
            const int b = u.pm >> 5, s0 = (u.pm & 31) * 256 + wr * 64 + fr;
#pragma unroll
            for (int bj = 0; bj < 2; ++bj) { const int hh = u.pn * 2 + bj, which = hh >> 3, h = hh & 7;
                bf16_t* hb = qkvf + ((size_t)((which * NB + b) * NHD + h) * SEQ) * 128 + wc * 32 + 8 * fq;
#pragma unroll
                for (int ai = 0; ai < 2; ++ai)
#pragma unroll
                    for (int m = 0; m < 4; ++m) { const f32x4 v0 = acc[ai][bj][m][0], v1 = acc[ai][bj][m][1];
                        *(u32x4*)(hb + (size_t)(s0 + ai * 128 + m * 16) * 128) = (u32x4){cvtpk(v0[0], v0[1]), cvtpk(v0[2], v0[3]), cvtpk(v1[0], v1[1]), cvtpk(v1[2], v1[3])}; } }
            return;
        }
        bf16_t* base; int ld, ct;
        if (u.pn < 24) { base = qkvg; ld = 3072; ct = u.pn - 12; } else { base = z; ld = 1024; ct = u.pn - 24; }
        const int col0 = ct * 256 + wc * 32 + 8 * fq;
#pragma unroll
        for (int ai = 0; ai < 2; ++ai)
#pragma unroll
            for (int m = 0; m < 4; ++m) { bf16_t* rowp = base + (size_t)(row0 + ai * 128 + m * 16) * ld + col0;
#pragma unroll
                for (int bj = 0; bj < 2; ++bj) { const f32x4 v0 = acc[ai][bj][m][0], v1 = acc[ai][bj][m][1];
                    *(u32x4*)(rowp + bj * 128) = (u32x4){cvtpk(v0[0], v0[1]), cvtpk(v0[2], v0[3]), cvtpk(v1[0], v1[1]), cvtpk(v1[2], v1[3])}; } }
    }
};
__device__ __forceinline__ void mod_task(const Params& p, int t, const float* cond, float* red) {
    const int tid = opaque_tid(), wv = tid >> 6, lane = tid & 63, col = t * 64 + lane;
    float a0 = 0.f, a1 = 0.f, a2 = 0.f, a3 = 0.f;
    const float* w = p.ada_w + (size_t)(wv * 256) * NMOD + col;
    const float* cd = cond + wv * 256;
#pragma unroll 32
    for (int k = 0; k < 256; ++k) { const float v = w[(size_t)k * NMOD]; a0 += cd[k] * v; a1 += cd[2048 + k] * v; a2 += cd[4096 + k] * v; a3 += cd[6144 + k] * v; }
    red[(wv * 4 + 0) * 64 + lane] = a0; red[(wv * 4 + 1) * 64 + lane] = a1; red[(wv * 4 + 2) * 64 + lane] = a2; red[(wv * 4 + 3) * 64 + lane] = a3;
    __syncthreads();
    if (tid < 256) { const int b = tid >> 6; float s = p.ada_b[col];
#pragma unroll
        for (int w8 = 0; w8 < 8; ++w8) s += red[(w8 * 4 + b) * 64 + lane];
        p.MOD_()[(size_t)b * NMOD + col] = s; }
    __syncthreads();
}
__device__ __forceinline__ const float* wmap_col(int mode, const float* s0, const float* s1, int r) {
    if (mode == 0) return s0 + r;
    if (mode == 1) { const int pn = r >> 8, bj = (r >> 7) & 1, u = r & 127; return (bj ? s1 : s0) + 128 * pn + u; }
    int c;
    if (r < 3072) c = r; else if (r < 6144) c = 3080 + (r - 3072); else if (r < 7168) c = 6168 + (r - 6144);
    else if (r < 7176) c = 3072 + (r - 7168); else if (r < 7184) c = 6152 + (r - 7176); else if (r < 7192) c = 6160 + (r - 7184); else return nullptr;
    return s0 + c;
}
constexpr int CT_GU = 176 * 32, CT_D = 32 * 88, CT_IN = 116 * 32, CT_OUT = 32 * 32;
struct ConvJob { const float* s0; const float* s1; bf16_t* dst; int mode, ld, K, ntn, idx; };
__device__ __forceinline__ ConvJob conv_job_ffn(const Params& p, int l, int idx) {
    ConvJob j;
    if (idx < CT_GU) { j.s0 = p.wg + (size_t)l * DM * DFF; j.s1 = p.wu + (size_t)l * DM * DFF; j.dst = p.WGU_(); j.mode = 1; j.ld = DFF; j.K = DM; j.ntn = 176; j.idx = idx; }
    else { j.s0 = p.wd + (size_t)l * DFF * DM; j.s1 = nullptr; j.dst = p.WD_(); j.mode = 0; j.ld = DM; j.K = DFF; j.ntn = 32; j.idx = idx - CT_GU; }
    return j;
}
__device__ __forceinline__ ConvJob conv_job0(const Params& p, int t) {
    constexpr int NT0 = CT_GU + CT_D, NT1 = NT0 + CT_IN;
    if (t < NT0) return conv_job_ffn(p, 0, t);
    ConvJob j; j.s1 = nullptr; j.K = DM;
    if (t < NT1) { j.s0 = p.w_in; j.dst = p.WIN_(); j.mode = 2; j.ld = 7192; j.ntn = 116; j.idx = t - NT0; }
    else { j.s0 = p.w_out; j.dst = p.WOUT_(); j.mode = 0; j.ld = DM; j.ntn = 32; j.idx = t - NT1; }
    return j;
}
__device__ __forceinline__ void conv_load(const ConvJob& j, int tid, float (&v)[8]) {
    const int n0 = (j.idx % j.ntn) * 64, k0 = (j.idx / j.ntn) * 64, n = tid & 63, kq = tid >> 6;
    const float* cp = wmap_col(j.mode, j.s0, j.s1, n0 + n);
#pragma unroll
    for (int i = 0; i < 8; ++i) v[i] = cp ? cp[(size_t)(k0 + i * 8 + kq) * j.ld] : 0.f;
}
__device__ __forceinline__ void conv_store(const ConvJob& j, int tid, const float (&v)[8], float* tile) {
    const int n0 = (j.idx % j.ntn) * 64, k0 = (j.idx / j.ntn) * 64, n = tid & 63, kq = tid >> 6;
#pragma unroll
    for (int i = 0; i < 8; ++i) tile[n * 65 + i * 8 + kq] = v[i];
    __syncthreads();
    const int n2 = tid >> 3, kg = tid & 7; const float* tp = tile + n2 * 65 + kg * 8;
    *(u32x4*)(j.dst + (size_t)(n0 + n2) * j.K + k0 + kg * 8) = (u32x4){cvtpk(tp[0], tp[1]), cvtpk(tp[2], tp[3]), cvtpk(tp[4], tp[5]), cvtpk(tp[6], tp[7])};
    __syncthreads();
}
template <int LIST> __device__ __forceinline__ void conv_run(const Params& p, int NT, float* tile) {
    const int tid = opaque_tid(), G = gridDim.x;
    for (int t = blockIdx.x; t < NT; t += 4 * G) {
        float v[4][8]; ConvJob j[4];
#pragma unroll
        for (int q = 0; q < 4; ++q) { const int tq = t + q * G; if (tq < NT) { j[q] = LIST ? conv_job_ffn(p, 1, tq) : conv_job0(p, tq); conv_load(j[q], tid, v[q]); } }
#pragma unroll
        for (int q = 0; q < 4; ++q) { const int tq = t + q * G; if (tq < NT) conv_store(j[q], tid, v[q], tile); }
    }
}
__device__ __forceinline__ void phase_prologue(const Params& p, unsigned char* lds) {
    float* cond = (float*)lds; float* red = cond + 8192; float* tile = (float*)lds;
    const int tid = opaque_tid();
    if ((int)blockIdx.x < 288) {
        for (int i = tid; i < 8192; i += 512) { const float c = p.c[i]; cond[i] = c / (1.f + __expf(-c)); }
        __syncthreads();
        for (int t = blockIdx.x; t < 288; t += gridDim.x) mod_task(p, t, cond, red);
    }
    for (int i = blockIdx.x * 512 + tid; i < 2 * MTOK; i += gridDim.x * 512) p.ROWSS_()[i] = 0.f;
    conv_run<0>(p, CT_GU + CT_D + CT_IN + CT_OUT, tile);
}
__device__ __forceinline__ void phase_cb(const bf16_t* W, int N, const float* shift  , float* cb) {
    const int tid = opaque_tid(), lane = tid & 63, gw = blockIdx.x * 8 + (tid >> 6), GW = gridDim.x * 8, b = gw & 3;
    f32x4 sh[4][2];
#pragma unroll
    for (int q = 0; q < 4; ++q) { const float* sp = shift + (size_t)b * NMOD + 8 * (lane + 64 * q); sh[q][0] = *(const f32x4*)sp; sh[q][1] = *(const f32x4*)(sp + 4); }
    for (int n = gw >> 2; n < N; n += GW >> 2) {
        float a = 0.f;
#pragma unroll
        for (int q = 0; q < 4; ++q) { const u32x4 w = *(const u32x4*)(W + (size_t)n * DM + 8 * (lane + 64 * q));
            a += bflo(w[0]) * sh[q][0][0] + bfhi(w[0]) * sh[q][0][1] + bflo(w[1]) * sh[q][0][2] + bfhi(w[1]) * sh[q][0][3]
               + bflo(w[2]) * sh[q][1][0] + bfhi(w[2]) * sh[q][1][1] + bflo(w[3]) * sh[q][1][2] + bfhi(w[3]) * sh[q][1][3]; }
        a = wave_sum(a);
        if (lane == 0) cb[(size_t)b * N + n] = a;
    }
}
__device__ __forceinline__ void phase_norm(const float* xin, const float* g, const float* mod, int shift_idx, int scale_idx, bf16_t* h) {
    const int tid = opaque_tid(), lane = tid & 63, gw = blockIdx.x * 8 + (tid >> 6), GW = gridDim.x * 8;
    for (int row = gw; row < MTOK; row += GW) {
        const int b = row >> 13; const float* xr = xin + (size_t)row * DM;
        f32x4 v[8]; float ss = 0.f;
#pragma unroll
        for (int i = 0; i < 8; ++i) { v[i] = *(const f32x4*)(xr + 4 * (lane + 64 * i)); ss += v[i][0] * v[i][0] + v[i][1] * v[i][1] + v[i][2] * v[i][2] + v[i][3] * v[i][3]; }
        ss = wave_sum(ss); const float r = __builtin_amdgcn_rsqf(ss * (1.f / DM) + 1e-6f);
        const float* sh = mod + (size_t)b * NMOD + shift_idx * DM; const float* sc = mod + (size_t)b * NMOD + scale_idx * DM;
#pragma unroll
        for (int i = 0; i < 8; ++i) { const int col = 4 * (lane + 64 * i);
            const f32x4 gg = *(const f32x4*)(g + col), s1 = *(const f32x4*)(sc + col), s0 = *(const f32x4*)(sh + col);
            const f32x4 y = v[i] * r * gg * (s1 + 1.f) + s0;
            *(u32x2*)(h + (size_t)row * DM + col) = (u32x2){cvtpk(y[0], y[1]), cvtpk(y[2], y[3])}; }
    }
}
__device__ __forceinline__ void phase_final_norm(float* x, const float* g) {
    const int tid = opaque_tid(), lane = tid & 63, gw = blockIdx.x * 8 + (tid >> 6), GW = gridDim.x * 8;
    for (int row = gw; row < MTOK; row += GW) {
        float* xr = x + (size_t)row * DM;
        f32x4 v[8]; float ss = 0.f;
#pragma unroll
        for (int i = 0; i < 8; ++i) { v[i] = *(const f32x4*)(xr + 4 * (lane + 64 * i)); ss += v[i][0] * v[i][0] + v[i][1] * v[i][1] + v[i][2] * v[i][2] + v[i][3] * v[i][3]; }
        ss = wave_sum(ss); const float r = __builtin_amdgcn_rsqf(ss * (1.f / DM) + 1e-6f);
#pragma unroll
        for (int i = 0; i < 8; ++i) { const int col = 4 * (lane + 64 * i); *(f32x4*)(xr + col) = v[i] * r * *(const f32x4*)(g + col); }
    }
}
__device__ __forceinline__ void phase_gdn_out(const Params& p) {
    const int tid = opaque_tid(), lane = tid & 63, half = lane >> 5, l32 = lane & 31, gw = blockIdx.x * 8 + (tid >> 6), GW = gridDim.x * 8;
    const f32x4 gn = *(const f32x4*)(p.gdn_out_norm + 4 * l32);
    for (int it = gw; it < MTOK * NHD / 2; it += GW) {
        const int grp = it * 2 + half, row = grp >> 3, h = grp & 7;
        const f32x4 v = *(const f32x4*)(p.OG_() + (size_t)row * 1024 + h * 128 + 4 * l32);
        const u32x2 zz = *(const u32x2*)(p.Z_() + (size_t)row * 1024 + h * 128 + 4 * l32);
        float ss = v[0] * v[0] + v[1] * v[1] + v[2] * v[2] + v[3] * v[3];
        ss += __shfl_xor(ss, 1); ss += __shfl_xor(ss, 2); ss += __shfl_xor(ss, 4); ss += __shfl_xor(ss, 8); ss += __shfl_xor(ss, 16);
        const float r = __builtin_amdgcn_rsqf(ss * (1.f / 128.f) + 1e-6f);
        const float y0 = v[0] * r * gn[0] * silu_f(bflo(zz[0])), y1 = v[1] * r * gn[1] * silu_f(bfhi(zz[0]));
        const float y2 = v[2] * r * gn[2] * silu_f(bflo(zz[1])), y3 = v[3] * r * gn[3] * silu_f(bfhi(zz[1]));
        *(u32x2*)(p.H_() + (size_t)row * DM + 1024 + h * 128 + 4 * l32) = (u32x2){cvtpk(y0, y1), cvtpk(y2, y3)};
    }
}
__device__ __forceinline__ void cumsum_task(const Params& p, int bh, float* wsum) {
    const int tid = opaque_tid(), wv = tid >> 6, lane = tid & 63, b = bh >> 3, h = bh & 7;
    const float fb = p.fox_f_bias[h];
    float loc[16]; float run = 0.f;
#pragma unroll
    for (int i = 0; i < 16; ++i) { const float xv = p.SMALL_()[(size_t)(b * SEQ + tid * 16 + i) * 32 + h] + fb; run += fminf(xv, 0.f) - log1pf(__expf(-fabsf(xv))); loc[i] = run; }
    float inc = run;
#pragma unroll
    for (int o = 1; o < 64; o <<= 1) { const float t = __shfl_up(inc, o); if (lane >= o) inc += t; }
    if (lane == 63) wsum[wv] = inc;
    __syncthreads();
    float off = inc - run;
    for (int w8 = 0; w8 < wv; ++w8) off += wsum[w8];
#pragma unroll
    for (int i = 0; i < 16; ++i) p.BIAS_()[(size_t)bh * SEQ + tid * 16 + i] = -(off + loc[i]) * 11.313708498984761f;
    __syncthreads();
}
constexpr int G1L_QS = 0, G1L_KS = 17408, G1L_KBS = 34816, G1L_XT = 0, G1L_DL = 36864, G1L_RU = 53248, G1L_RW = 86016, G1L_LS = 118784, G1L_LB = 135168, G1L_GC = 144384, G1L_BETA = 144640, G1L_CW = 144896;
struct G1X { u32x4 x[2][4][2]; float al, bl; };
__device__ __forceinline__ void g1_prefetch(G1X& X, const Params& p, int b, int h, int t0, int tid) {
    const int tok = tid >> 3, ch0 = (tid & 7) * 16;
#pragma unroll
    for (int part = 0; part < 2; ++part)
#pragma unroll
        for (int kk = 0; kk < 4; ++kk) { const int tt = t0 + tok - 3 + kk;
            X.x[part][kk][0] = (u32x4){0u, 0u, 0u, 0u}; X.x[part][kk][1] = X.x[part][kk][0];
            if (tt >= 0) { const bf16_t* xp = p.QKVG_() + (size_t)(b * SEQ + tt) * 3072 + part * 1024 + h * 128 + ch0; X.x[part][kk][0] = *(const u32x4*)xp; X.x[part][kk][1] = *(const u32x4*)(xp + 8); } }
    if (tid < 64) { const size_t row = (size_t)(b * SEQ + t0 + tid); X.al = p.SMALL_()[row * 32 + 8 + h]; X.bl = p.SMALL_()[row * 32 + 16 + h]; }
}
__device__ __forceinline__ void g1_conv_part(const u32x4 (&xx)[4][2], int part, const float* cw, int ch0, float (&y)[16]) {
#pragma unroll
    for (int e = 0; e < 16; ++e) y[e] = 0.f;
#pragma unroll
    for (int kk = 0; kk < 4; ++kk) {
        const u32x4 x0 = xx[kk][0], x1 = xx[kk][1];
        const float* wp = cw + (kk * 3 + part) * 128 + ch0;
        const f32x4 w0 = *(const f32x4*)wp, w1 = *(const f32x4*)(wp + 4), w2 = *(const f32x4*)(wp + 8), w3 = *(const f32x4*)(wp + 12);
        y[0] += w0[0] * bflo(x0[0]); y[1] += w0[1] * bfhi(x0[0]); y[2] += w0[2] * bflo(x0[1]); y[3] += w0[3] * bfhi(x0[1]);
        y[4] += w1[0] * bflo(x0[2]); y[5] += w1[1] * bfhi(x0[2]); y[6] += w1[2] * bflo(x0[3]); y[7] += w1[3] * bfhi(x0[3]);
        y[8] += w2[0] * bflo(x1[0]); y[9] += w2[1] * bfhi(x1[0]); y[10] += w2[2] * bflo(x1[1]); y[11] += w2[3] * bfhi(x1[1]);
        y[12] += w3[0] * bflo(x1[2]); y[13] += w3[1] * bfhi(x1[2]); y[14] += w3[2] * bflo(x1[3]); y[15] += w3[3] * bfhi(x1[3]);
    }
#pragma unroll
    for (int e = 0; e < 16; ++e) y[e] = silu_f(y[e]);
}
__device__ __forceinline__ void st16_bf16(unsigned char* dst, const float (&y)[16], float s) {
    *(u32x4*)dst = (u32x4){cvtpk(y[0] * s, y[1] * s), cvtpk(y[2] * s, y[3] * s), cvtpk(y[4] * s, y[5] * s), cvtpk(y[6] * s, y[7] * s)};
    *(u32x4*)(dst + 16) = (u32x4){cvtpk(y[8] * s, y[9] * s), cvtpk(y[10] * s, y[11] * s), cvtpk(y[12] * s, y[13] * s), cvtpk(y[14] * s, y[15] * s)};
}
__device__ __forceinline__ void st16_f32(float* dst, const float (&y)[16], float s) {
#pragma unroll
    for (int q = 0; q < 4; ++q) *(f32x4*)(dst + 4 * q) = (f32x4){y[4 * q] * s, y[4 * q + 1] * s, y[4 * q + 2] * s, y[4 * q + 3] * s};
}
__device__ __forceinline__ void g1_task(const Params& p, int b, int h, int n, G1X& X, bool has_next, int nb, int nt0, unsigned char* lds) {
    const int tid = opaque_tid(), wv = __builtin_amdgcn_readfirstlane(tid >> 6), lane = tid & 63, fr = lane & 15, fq = lane >> 4;
    const int task = (b * NHD + h) * NCHUNK + n, t0 = n * CH;
    float* gcs = (float*)(lds + G1L_GC); float* betas = (float*)(lds + G1L_BETA); float* LS = (float*)(lds + G1L_LS); const float* cw = (const float*)(lds + G1L_CW);
    unsigned char* gout = p.G1OUT_() + (size_t)task * G1_BYTES;
    if (wv == 0) {
        const float g = -__expf(p.gdn_A_log[h]) * softplus_f(X.al + p.gdn_dt_bias[h]);
        float inc = g;
#pragma unroll
        for (int o = 1; o < 64; o <<= 1) { const float t = __shfl_up(inc, o); if (lane >= o) inc += t; }
        gcs[lane] = inc; betas[lane] = 1.f / (1.f + __expf(-X.bl));
        if (lane == 63) p.GL_()[task] = __expf(inc);
    }
    __syncthreads();
    {
        const int tok = tid >> 3, ch0 = (tid & 7) * 16;
        const float gc = gcs[tok], beta = betas[tok], eg = __expf(gc);
        float y[16];
        u32x4 xv[4][2];
#pragma unroll
        for (int kk = 0; kk < 4; ++kk) { const int tt = t0 + tok - 3 + kk; xv[kk][0] = (u32x4){0u, 0u, 0u, 0u}; xv[kk][1] = xv[kk][0];
            if (tt >= 0) { const bf16_t* xp = p.QKVG_() + (size_t)(b * SEQ + tt) * 3072 + 2048 + h * 128 + ch0; xv[kk][0] = *(const u32x4*)xp; xv[kk][1] = *(const u32x4*)(xp + 8); } }
        g1_conv_part(X.x[1], 1, cw, ch0, y);
        { float ss = 0.f;
#pragma unroll
          for (int e = 0; e < 16; ++e) ss += y[e] * y[e];
          ss += __shfl_xor(ss, 1); ss += __shfl_xor(ss, 2); ss += __shfl_xor(ss, 4);
          const float inv = __builtin_amdgcn_rsqf(ss + 1e-6f);
          st16_bf16(lds + G1L_KS + tok * 272 + ch0 * 2, y, inv);
          st16_bf16(lds + G1L_KBS + tok * 272 + ch0 * 2, y, inv * beta);
          st16_f32((float*)(lds + G1L_RW) + tok * 128 + ch0, y, inv * beta * eg); }
        __builtin_amdgcn_sched_barrier(0);
        g1_conv_part(X.x[0], 0, cw, ch0, y);
        { float ss = 0.f;
#pragma unroll
          for (int e = 0; e < 16; ++e) ss += y[e] * y[e];
          ss += __shfl_xor(ss, 1); ss += __shfl_xor(ss, 2); ss += __shfl_xor(ss, 4);
          const float inv = __builtin_amdgcn_rsqf(ss + 1e-6f) * 0.08838834764831845f;
          st16_bf16(lds + G1L_QS + tok * 272 + ch0 * 2, y, inv);
          st16_bf16(gout + G1_QG + (tok * 128 + ch0) * 2, y, inv * eg); }
        __builtin_amdgcn_sched_barrier(0);
        g1_conv_part(xv, 2, cw, ch0, y);
        st16_f32((float*)(lds + G1L_RU) + tok * 128 + ch0, y, beta);
    }
    __syncthreads();
    if (has_next) g1_prefetch(X, p, nb, h, nt0, tid);
    {
        const int which = wv >> 2, mi = wv & 3;
        const unsigned char* Ab = lds + (which ? G1L_QS : G1L_KBS) + (mi * 16 + fr) * 272 + fq * 16;
        const unsigned char* Bb = lds + G1L_KS + fr * 272 + fq * 16;
        f32x4 acc[4];
#pragma unroll
        for (int nj = 0; nj < 4; ++nj) acc[nj] = (f32x4){0.f, 0.f, 0.f, 0.f};
#pragma unroll
        for (int k = 0; k < 4; ++k) { const bf16x8 a = *(const bf16x8*)(Ab + k * 64);
#pragma unroll
            for (int nj = 0; nj < 4; ++nj) if (nj <= mi) { const bf16x8 bb = *(const bf16x8*)(Bb + nj * 16 * 272 + k * 64); acc[nj] = __builtin_amdgcn_mfma_f32_16x16x32_bf16(a, bb, acc[nj], 0, 0, 0); } }
        bf16_t* AQ = (bf16_t*)(gout + G1_AQ);
#pragma unroll
        for (int nj = 0; nj < 4; ++nj) { const int jj = nj * 16 + fr; const float gj = gcs[jj];
#pragma unroll
            for (int j = 0; j < 4; ++j) { const int i = mi * 16 + fq * 4 + j; const float dv = acc[nj][j] * __expf(gcs[i] - gj);
                if (which == 0) { const float lv = (nj <= mi && jj < i) ? dv : 0.f; if (nj <= mi) LS[i * 64 + jj] = lv; *(bf16_t*)(lds + G1L_LB + i * 144 + jj * 2) = (bf16_t)(cvtpk(lv, 0.f) & 0xffffu); }
                else { const float o = (nj <= mi && jj <= i) ? dv : 0.f; AQ[i * 64 + jj] = (bf16_t)(cvtpk(o, 0.f) & 0xffffu); } } }
        const int c = tid >> 2, tg = tid & 3; const float gl = gcs[63];
        float kv[16];
#pragma unroll
        for (int e = 0; e < 16; ++e) { const int t = tg * 16 + e; kv[e] = bf2f(*(const bf16_t*)(lds + G1L_KS + t * 272 + c * 2)) * __expf(gl - gcs[t]); }
        st16_bf16(gout + G1_KDT + (c * 64 + tg * 16) * 2, kv, 1.f);
    }
    __syncthreads();
    {
        unsigned char* XT = lds + G1L_XT; float* DL = (float*)(lds + G1L_DL);
        for (int i = tid; i < 36864 / 16; i += 512) ((u32x4*)XT)[i] = (u32x4){0u, 0u, 0u, 0u};
        __syncthreads();
        const int c = (wv & 3) * 64 + lane;
        const float* rhs = (const float*)(lds + (c < 128 ? G1L_RU : G1L_RW)) + (c & 127);
        int vz; asm volatile("v_mov_b32 %0, 0" : "=v"(vz));
        const float* LSv = LS + vz;
#pragma unroll 1
        for (int I = 0; I < 4; ++I) {
            if (I > 0) {
#pragma unroll
                for (int t2 = 0; t2 < 2; ++t2) { const int ct = 2 * wv + t2;
                    f32x4 d = (f32x4){0.f, 0.f, 0.f, 0.f};
#pragma unroll
                    for (int ks = 0; ks < 2; ++ks) { if (ks == 1 && I < 3) break;
                        const bf16x8 a = *(const bf16x8*)(lds + G1L_LB + (16 * I + fr) * 144 + (ks * 32 + fq * 8) * 2);
                        const bf16x8 bx = *(const bf16x8*)(XT + (16 * ct + fr) * 144 + (ks * 32 + fq * 8) * 2);
                        d = __builtin_amdgcn_mfma_f32_16x16x32_bf16(a, bx, d, 0, 0, 0); }
#pragma unroll
                    for (int j = 0; j < 4; ++j) DL[(fq * 4 + j) * 256 + 16 * ct + fr] = d[j]; }
                __syncthreads();
            }
            if (wv < 4) {
                float r[16];
#pragma unroll
                for (int i = 0; i < 16; ++i) { r[i] = rhs[(16 * I + i) * 128]; if (I > 0) r[i] -= DL[i * 256 + c]; }
#pragma unroll
                for (int i = 1; i < 16; ++i) { float a = r[i];
#pragma unroll
                    for (int jq = 0; jq < (i + 3) / 4; ++jq) { const f32x4 l = *(const f32x4*)(LSv + (16 * I + i) * 64 + 16 * I + jq * 4);
#pragma unroll
                        for (int e = 0; e < 4; ++e) if (jq * 4 + e < i) a -= l[e] * r[jq * 4 + e]; }
                    r[i] = a; }
                const u32x4 p0 = (u32x4){cvtpk(r[0], r[1]), cvtpk(r[2], r[3]), cvtpk(r[4], r[5]), cvtpk(r[6], r[7])}, p1 = (u32x4){cvtpk(r[8], r[9]), cvtpk(r[10], r[11]), cvtpk(r[12], r[13]), cvtpk(r[14], r[15])};
                if (I < 3) { *(u32x4*)(XT + c * 144 + I * 32) = p0; *(u32x4*)(XT + c * 144 + I * 32 + 16) = p1; }
                if (c < 128) { unsigned char* up = gout + G1_UT + c * 128 + I * 32; *(u32x4*)up = p0; *(u32x4*)(up + 16) = p1; }
                else { bf16_t* wp = (bf16_t*)(gout + G1_W) + (16 * I) * 128 + (c - 128);
#pragma unroll
                    for (int i = 0; i < 16; ++i) wp[i * 128] = (bf16_t)(cvtpk(r[i], 0.f) & 0xffffu); }
            }
            __syncthreads();
        }
    }
}
__device__ __forceinline__ void phase_g1(const Params& p, unsigned char* lds) {
    const int tid = opaque_tid();
    for (int t = blockIdx.x; t < 32; t += gridDim.x) cumsum_task(p, t, (float*)lds);
    for (int vb = blockIdx.x; vb < 256; vb += gridDim.x) {
        const int h = vb & 7, i0 = vb >> 3;
        float* cw = (float*)(lds + G1L_CW);
        for (int i = tid; i < 4 * 3 * 128; i += 512) { const int kk = i / 384, r = i - kk * 384, part = r >> 7, ch = r & 127; cw[i] = p.gdn_conv[(size_t)kk * 3072 + part * 1024 + h * 128 + ch]; }
        G1X X;
        g1_prefetch(X, p, i0 >> 7, h, (i0 & 127) * CH, tid);
        __syncthreads();
#pragma unroll 1
        for (int i = 0; i < 16; ++i) { const int idx = i0 + 32 * i, idn = idx + 32;
            g1_task(p, idx >> 7, h, idx & 127, X, i + 1 < 16, idn >> 7, (idn & 127) * CH, lds); }
    }
}
struct G2Regs { bf16x8 wa[4], qa[4], aa[2], kda[2][2]; u32x2 u4; float dec; };
__device__ __forceinline__ void g2_load(G2Regs& R, const Params& p, int task, int mt, int sl, int fr, int fq) {
    const unsigned char* base = p.G1OUT_() + (size_t)task * G1_BYTES;
#pragma unroll
    for (int k = 0; k < 4; ++k) { R.wa[k] = *(const bf16x8*)(base + G1_W + ((16 * mt + fr) * 128 + k * 32 + fq * 8) * 2); R.qa[k] = *(const bf16x8*)(base + G1_QG + ((16 * mt + fr) * 128 + k * 32 + fq * 8) * 2); }
#pragma unroll
    for (int k2 = 0; k2 < 2; ++k2) { R.aa[k2] = *(const bf16x8*)(base + G1_AQ + ((16 * mt + fr) * 64 + k2 * 32 + fq * 8) * 2);
#pragma unroll
        for (int m2 = 0; m2 < 2; ++m2) R.kda[m2][k2] = *(const bf16x8*)(base + G1_KDT + ((16 * (2 * mt + m2) + fr) * 64 + k2 * 32 + fq * 8) * 2); }
    R.u4 = *(const u32x2*)(base + G1_UT + ((16 * sl + fr) * 64 + 16 * mt + 4 * fq) * 2);
    R.dec = p.GL_()[task];
}
#define G2_WARMN 4
#define G2_DMA(ptr) do { unsigned sv_; asm volatile("s_mov_b32 %0, m0\n\ts_mov_b32 m0, %2\n\ts_nop 0\n\tglobal_load_lds_dword %1, off\n\ts_mov_b32 m0, %0" : "=&s"(sv_) : "v"(ptr), "s"(m0v) : "memory"); } while (0)
__device__ __forceinline__ void g2_consume(G2Regs& cur, G2Regs& nxt, f32x4 (&sacc)[2], const Params& p, unsigned char* ST, unsigned char* VT,
                                           int n, int bh, int sl, int b, int h, int wv, int lane, int fr, int fq, int mt, unsigned m0v) {
    f32x4 dq = (f32x4){0.f, 0.f, 0.f, 0.f}, dw = dq;
    if (false && wv >= 4 && n + G2_WARMN < NCHUNK) {
        const int li = (wv - 4) * 64 + lane; const unsigned char* w_ = p.G1OUT_() + (size_t)(bh * 128 + n + G2_WARMN) * G1_BYTES;
        const unsigned char* a0_ = w_ + G1_W + li * 128; G2_DMA(a0_);
        if (li < 192) { const unsigned char* a1_ = a0_ + 32768; G2_DMA(a1_); }
        if (li < 16) { const unsigned char* a2_ = w_ + G1_UT + (16 * sl + li) * 128; G2_DMA(a2_); }
    }
    if (wv < 4) {
        if (n + 1 < NCHUNK) g2_load(nxt, p, bh * 128 + n + 1, mt, sl, fr, fq);
        asm volatile("" ::: "memory");
#pragma unroll
        for (int k = 0; k < 4; ++k) { const bf16x8 sb = *(const bf16x8*)(ST + fr * 272 + k * 64 + fq * 16);
            dw = __builtin_amdgcn_mfma_f32_16x16x32_bf16(cur.wa[k], sb, dw, 0, 0, 0); dq = __builtin_amdgcn_mfma_f32_16x16x32_bf16(cur.qa[k], sb, dq, 0, 0, 0); }
        const float v0 = bflo(cur.u4[0]) - dw[0], v1 = bfhi(cur.u4[0]) - dw[1], v2 = bflo(cur.u4[1]) - dw[2], v3 = bfhi(cur.u4[1]) - dw[3];
        *(u32x2*)(VT + fr * 144 + (16 * mt + 4 * fq) * 2) = (u32x2){cvtpk(v0, v1), cvtpk(v2, v3)};
    }
    __syncthreads();
    if (wv < 4) {
        const bf16x8 vb0 = *(const bf16x8*)(VT + fr * 144 + fq * 16), vb1 = *(const bf16x8*)(VT + fr * 144 + 64 + fq * 16);
        dq = __builtin_amdgcn_mfma_f32_16x16x32_bf16(cur.aa[0], vb0, dq, 0, 0, 0); dq = __builtin_amdgcn_mfma_f32_16x16x32_bf16(cur.aa[1], vb1, dq, 0, 0, 0);
        float* op = p.OG_() + (size_t)(b * SEQ + n * CH + 16 * mt + 4 * fq) * 1024 + h * 128 + 16 * sl + fr;
#pragma unroll
        for (int j = 0; j < 4; ++j) op[(size_t)j * 1024] = dq[j];
#pragma unroll
        for (int m2 = 0; m2 < 2; ++m2) { sacc[m2] = sacc[m2] * cur.dec;
            sacc[m2] = __builtin_amdgcn_mfma_f32_16x16x32_bf16(cur.kda[m2][0], vb0, sacc[m2], 0, 0, 0); sacc[m2] = __builtin_amdgcn_mfma_f32_16x16x32_bf16(cur.kda[m2][1], vb1, sacc[m2], 0, 0, 0);
            *(u32x2*)(ST + fr * 272 + (16 * (2 * mt + m2) + 4 * fq) * 2) = (u32x2){cvtpk(sacc[m2][0], sacc[m2][1]), cvtpk(sacc[m2][2], sacc[m2][3])}; }
    }
    __syncthreads();
}
__device__ __forceinline__ void phase_g2(const Params& p, unsigned char* lds) {
    const int tid = opaque_tid(), wv = __builtin_amdgcn_readfirstlane(tid >> 6), lane = tid & 63, fr = lane & 15, fq = lane >> 4, mt = wv & 3;
    const unsigned m0v = (unsigned)__builtin_amdgcn_readfirstlane((int)(uintptr_t)(lds + 10752 + (wv & 3) * 256));
    unsigned char* ST = lds; unsigned char* VT = lds + 4352;
    for (int ub = blockIdx.x; ub < 256; ub += gridDim.x) {
        const int xcd = ub & 7, idx = ub >> 3, bh = xcd * 4 + (idx >> 3), sl = idx & 7, b = bh >> 3, h = bh & 7;
        for (int i = tid; i < 4352 / 4; i += 512) ((unsigned*)ST)[i] = 0u;
        f32x4 sacc[2]; sacc[0] = (f32x4){0.f, 0.f, 0.f, 0.f}; sacc[1] = sacc[0];
        G2Regs A, B;
        if (wv < 4) g2_load(A, p, bh * 128, mt, sl, fr, fq);
        __syncthreads();
#pragma unroll 1
        for (int n = 0; n < NCHUNK; n += 2) {
            g2_consume(A, B, sacc, p, ST, VT, n, bh, sl, b, h, wv, lane, fr, fq, mt, m0v);
            g2_consume(B, A, sacc, p, ST, VT, n + 1, bh, sl, b, h, wv, lane, fr, fq, mt, m0v);
        }
        asm volatile("s_waitcnt vmcnt(0)" ::: "memory");
        __syncthreads();
    }
}
namespace fa {
constexpr int D = 128;
constexpr int LDI = 128;
constexpr int LDO = 2048;
constexpr float THR = 8.f;
constexpr bool WSKIP = false;
constexpr float SCALE = 0.08838834764831845f;
constexpr int NW = 8, QBLK = 32, KVBLK = 64, QB = NW * QBLK;
constexpr int SHM_V = KVBLK * D * 2, SHM_K = KVBLK * D * 2;
constexpr int LDS_BYTES = 2 * SHM_V + 2 * SHM_K + NW * 64 * 4;

using bf16 = __hip_bfloat16;
typedef short bf16x8 __attribute__((ext_vector_type(8)));
typedef short s16x4 __attribute__((ext_vector_type(4)));
typedef float f32x16 __attribute__((ext_vector_type(16)));
typedef float f32x4 __attribute__((ext_vector_type(4)));
typedef unsigned u32x4 __attribute__((ext_vector_type(4)));
template <class A, class Bt> struct same_t { static constexpr bool v = false; };
template <class A> struct same_t<A, A> { static constexpr bool v = true; };

#define KSWZ(row, colB) ((row) * 256 + ((colB) ^ (((row) & 7) << 4)))
#define SBAR() __builtin_amdgcn_sched_barrier(0)
__device__ __forceinline__ int v_st(int k, int c) { const int kk = (k & ~0xC) | ((k & 4) << 1) | ((k & 8) >> 1); return ((kk >> 3) * 4 + (c >> 5)) * 512 + ((kk & 7) * 32 + (c & 31)) * 2; }
__device__ __forceinline__ int v_rd_base(int lane) { return ((lane & 3) << 3) | (((lane >> 2) & 3) << 6) | (((lane >> 4) & 1) << 5) | (((lane >> 5) & 1) << 8); }
constexpr int v_rd_off(int d0, int ks, int half) { return d0 * 512 + ks * 4096 + half * 2048; }
__device__ __forceinline__ int crow(int r, int hi) { return (r & 3) + 8 * (r >> 2) + 4 * hi; }
__device__ __forceinline__ unsigned cvtpk(float lo, float hi) {
    unsigned r; asm volatile("v_cvt_pk_bf16_f32 %0, %1, %2" : "=v"(r) : "v"(lo), "v"(hi)); return r;
}
__device__ __forceinline__ bf16x8 pack8(f32x4 a, f32x4 b) {
    u32x4 w = {cvtpk(a[0], a[1]), cvtpk(a[2], a[3]), cvtpk(b[0], b[1]), cvtpk(b[2], b[3])};
    return *reinterpret_cast<bf16x8*>(&w);
}
template <class T> __device__ __forceinline__ bf16x8 load8(const T* p) {
    if constexpr (same_t<T, float>::v) { return pack8(*(const f32x4*)p, *(const f32x4*)(p + 4)); }
    else { return *reinterpret_cast<const bf16x8*>(p); }
}
__device__ __forceinline__ void mask_tile(f32x16& p0, f32x16& p1, int dq, unsigned W) {
    const float NEG = -__builtin_inff();
#pragma unroll
    for (int r = 0; r < 16; ++r) {
        const int c = (r & 3) + 8 * (r >> 2);
        if ((unsigned)(dq - c) >= W) p0[r] = NEG;
        if ((unsigned)(dq - c - 32) >= W) p1[r] = NEG;
    }
}
__device__ __forceinline__ void partialSM(f32x16& p0, f32x16& p1, float& m_reg, float& mn, float& alpha) {
    float pmax = p0[0]; for (int r = 1; r < 16; ++r) pmax = fmaxf(pmax, p0[r]); for (int r = 0; r < 16; ++r) pmax = fmaxf(pmax, p1[r]);
    { auto rr = __builtin_amdgcn_permlane32_swap(__float_as_uint(pmax), __float_as_uint(pmax), false, false);
      pmax = fmaxf(__uint_as_float(rr[0]), __uint_as_float(rr[1])); }
    constexpr float C2 = 1.4426950408889634f * SCALE;
    if (__builtin_expect(__all((pmax - m_reg) * SCALE <= THR), 1)) { mn = m_reg; alpha = 1.f; }
    else { mn = fmaxf(m_reg, pmax); alpha = __builtin_amdgcn_exp2f((m_reg - mn) * C2); m_reg = mn; }
    const float mnL = -mn * C2;
    for (int r = 0; r < 16; ++r) p0[r] = fmaf(p0[r], C2, mnL); for (int r = 0; r < 16; ++r) p1[r] = fmaf(p1[r], C2, mnL);
    for (int r = 0; r < 16; ++r) p0[r] = __builtin_amdgcn_exp2f(p0[r]);
}
__device__ __forceinline__ void finishSM(f32x16& p0, f32x16& p1, float alpha, float& l_reg, bf16x8& pa0, bf16x8& pa1, bf16x8& pa2, bf16x8& pa3) {
    for (int r = 0; r < 16; ++r) p1[r] = __builtin_amdgcn_exp2f(p1[r]);
    float ps = 0; for (int r = 0; r < 16; ++r) ps += p0[r]; for (int r = 0; r < 16; ++r) ps += p1[r];
    { auto rr = __builtin_amdgcn_permlane32_swap(__float_as_uint(ps), __float_as_uint(ps), false, false);
      ps = __uint_as_float(rr[0]) + __uint_as_float(rr[1]); }
    l_reg = l_reg * alpha + ps;
#define PK4(P, B_, OUT) do { unsigned a0 = cvtpk(P[B_+0], P[B_+1]), a1 = cvtpk(P[B_+2], P[B_+3]);                          \
        unsigned b0 = cvtpk(P[B_+4], P[B_+5]), b1 = cvtpk(P[B_+6], P[B_+7]);                                             \
        auto r0 = __builtin_amdgcn_permlane32_swap(a0, b0, false, false); auto r1 = __builtin_amdgcn_permlane32_swap(a1, b1, false, false); \
        u32x4 w = {r0[0], r1[0], r0[1], r1[1]}; OUT = *reinterpret_cast<bf16x8*>(&w); } while (0)
    PK4(p0, 0, pa0); PK4(p0, 8, pa1); PK4(p1, 0, pa2); PK4(p1, 8, pa3);
#undef PK4
}
template <int KB, bool SK>
__device__ __forceinline__ void qkt(f32x16& p0, f32x16& p1, const char* K_lds, int r32, int hi, const bf16x8* qr, bool act, const float* bt) {
    if (SK && !act) { const float NEG = -__builtin_inff();
#pragma unroll
        for (int r = 0; r < 16; ++r) { p0[r] = NEG; p1[r] = NEG; } return; }
    { const f32x4 a0 = *(const f32x4*)(bt), a1 = *(const f32x4*)(bt + 8), a2 = *(const f32x4*)(bt + 16), a3 = *(const f32x4*)(bt + 24);
      const f32x4 c0 = *(const f32x4*)(bt + 32), c1 = *(const f32x4*)(bt + 40), c2 = *(const f32x4*)(bt + 48), c3 = *(const f32x4*)(bt + 56);
      p0 = (f32x16){a0[0], a0[1], a0[2], a0[3], a1[0], a1[1], a1[2], a1[3], a2[0], a2[1], a2[2], a2[3], a3[0], a3[1], a3[2], a3[3]};
      p1 = (f32x16){c0[0], c0[1], c0[2], c0[3], c1[0], c1[1], c1[2], c1[3], c2[0], c2[1], c2[2], c2[3], c3[0], c3[1], c3[2], c3[3]}; }
    const char* kb[4];
#pragma unroll
    for (int dd = 0; dd < 4; ++dd) kb[dd] = K_lds + KB * SHM_K + KSWZ(r32, (dd * 16 + hi * 8) * 2);
#pragma unroll
    for (int d0 = 0; d0 < 8; ++d0) { const char* a = kb[d0 & 3] + (d0 >> 2) * 128;
        bf16x8 b0 = *reinterpret_cast<const bf16x8*>(a);
        bf16x8 b1 = *reinterpret_cast<const bf16x8*>(a + 32 * 256);
        p0 = __builtin_amdgcn_mfma_f32_32x32x16_bf16(b0, qr[d0], p0, 0, 0, 0);
        p1 = __builtin_amdgcn_mfma_f32_32x32x16_bf16(b1, qr[d0], p1, 0, 0, 0); }
}
template <int VB, bool SK>
__device__ __forceinline__ void pv_tile(f32x16* o, int vb0, bf16x8 pa0, bf16x8 pa1, bf16x8 pa2, bf16x8 pa3, bool act) {
    if (SK && !act) return;
#define TRRD(dst, off) asm volatile("ds_read_b64_tr_b16 %0, %1 offset:%2" : "=&v"(dst) : "v"(vb0), "i"(off) : "memory")
#define PV_D0(d0) do { s16x4 l0, l1, l2, l3, h0, h1, h2, h3; constexpr int b_ = VB * SHM_V + v_rd_off(d0, 0, 0);     \
        TRRD(l0, b_); TRRD(h0, b_ + 2048); TRRD(l1, b_ + 4096); TRRD(h1, b_ + 6144); TRRD(l2, b_ + 8192); TRRD(h2, b_ + 10240); TRRD(l3, b_ + 12288); TRRD(h3, b_ + 14336); \
        asm volatile("s_waitcnt lgkmcnt(0)" ::: "memory"); SBAR();                 \
        o[d0] = __builtin_amdgcn_mfma_f32_32x32x16_bf16(pa0, (bf16x8){l0[0], l0[1], l0[2], l0[3], h0[0], h0[1], h0[2], h0[3]}, o[d0], 0, 0, 0);   \
        o[d0] = __builtin_amdgcn_mfma_f32_32x32x16_bf16(pa1, (bf16x8){l1[0], l1[1], l1[2], l1[3], h1[0], h1[1], h1[2], h1[3]}, o[d0], 0, 0, 0);   \
        o[d0] = __builtin_amdgcn_mfma_f32_32x32x16_bf16(pa2, (bf16x8){l2[0], l2[1], l2[2], l2[3], h2[0], h2[1], h2[2], h2[3]}, o[d0], 0, 0, 0);   \
        o[d0] = __builtin_amdgcn_mfma_f32_32x32x16_bf16(pa3, (bf16x8){l3[0], l3[1], l3[2], l3[3], h3[0], h3[1], h3[2], h3[3]}, o[d0], 0, 0, 0); } while (0)
    PV_D0(0); PV_D0(1); PV_D0(2); PV_D0(3);
#undef PV_D0
#undef TRRD
}

template <class TIn, class TOut> struct BlockRef { const TIn* Q; const TIn* K; const TIn* V; TOut* O; int P0; };
template <class TIn> struct Seam {
    bf16x8 qr[8];
    bf16x8 st_v0, st_v1, st_k0, st_k1; f32x4 sf0, sf1, sf2, sf3;
    f32x4 tq[16];
};
__device__ __forceinline__ int swa_jlo(int P0, int W) { const int lowk = P0 - W + 1; return lowk > 0 ? lowk / KVBLK : 0; }
#define ROW(p, k0, rr) ((p) + (size_t)((k0) + (rr)) * LDI + sc)
#define VMW() asm volatile("s_waitcnt vmcnt(0)" ::: "memory")
#define VMWN(n) asm volatile("s_waitcnt vmcnt(%0)" :: "i"(n) : "memory")
#define SLOAD_H(Kp, Vp, k0) do { S.st_v0 = load8<TIn>(ROW(Vp, k0, sr)); S.st_v1 = load8<TIn>(ROW(Vp, k0, 32 + sr));              \
                         S.st_k0 = load8<TIn>(ROW(Kp, k0, sr)); S.st_k1 = load8<TIn>(ROW(Kp, k0, 32 + sr)); } while (0)
#define SWRITE_HK(bf) do { *(bf16x8*)(K_lds + (bf) * SHM_K + kws) = S.st_k0; *(bf16x8*)(K_lds + (bf) * SHM_K + kws + 32 * 256) = S.st_k1; } while (0)
#define SWRITE_HV(bf) do { *(bf16x8*)(V_lds + (bf) * SHM_V + vst0) = S.st_v0; *(bf16x8*)(V_lds + (bf) * SHM_V + vst1) = S.st_v1; } while (0)
#define SWRITE_H(bf) do { SWRITE_HV(bf); SWRITE_HK(bf); } while (0)
#define SLOAD_F(p, k0) do { S.sf0 = *(const f32x4*)ROW(p, k0, sr); S.sf1 = *(const f32x4*)(ROW(p, k0, sr) + 4);                \
                            S.sf2 = *(const f32x4*)ROW(p, k0, 32 + sr); S.sf3 = *(const f32x4*)(ROW(p, k0, 32 + sr) + 4); } while (0)
#define SWRITE_KF(bf) do { *(bf16x8*)(K_lds + (bf) * SHM_K + kws) = pack8(S.sf0, S.sf1); *(bf16x8*)(K_lds + (bf) * SHM_K + kws + 32 * 256) = pack8(S.sf2, S.sf3); } while (0)
#define SWRITE_VF(bf) do { *(bf16x8*)(V_lds + (bf) * SHM_V + vst0) = pack8(S.sf0, S.sf1); *(bf16x8*)(V_lds + (bf) * SHM_V + vst1) = pack8(S.sf2, S.sf3); } while (0)
template <class TIn, class TOut>
__device__ __forceinline__ void causal_swa_prime(const BlockRef<TIn, TOut>& cur, int W, char* lds, Seam<TIn>& S) {
    constexpr bool F32 = same_t<TIn, float>::v;
    const int tid = opaque_tid(), wid = __builtin_amdgcn_readfirstlane(tid >> 6), lane = tid & 63, r32 = lane & 31, hi = lane >> 5;
    const int sr = tid >> 4, sc = (tid & 15) * 8, kws = KSWZ(sr, sc * 2); char* K_lds = lds + 2 * SHM_V;
    const int kb0 = swa_jlo(cur.P0, W) * KVBLK;
    for (int d0 = 0; d0 < 8; ++d0) S.qr[d0] = load8<TIn>(cur.Q + (size_t)(wid * QBLK + r32) * LDI + d0 * 16 + hi * 8);
    if constexpr (F32) { SLOAD_F((const float*)cur.K, kb0); VMW(); SWRITE_KF(0); SBAR(); SLOAD_F((const float*)cur.V, kb0); }
    else { SLOAD_H(cur.K, cur.V, kb0); VMW(); SWRITE_HK(0); }
    __syncthreads();
}
template <class TIn, class TOut>
__device__ __forceinline__ void causal_swa_block(const BlockRef<TIn, TOut>& cur, const BlockRef<TIn, TOut>& nxt, int skv, int W, char* lds, Seam<TIn>& S, const float* bias_l, const float* onorm) {
    constexpr bool F32 = same_t<TIn, float>::v;
    const int tid = opaque_tid(), wid = __builtin_amdgcn_readfirstlane(tid >> 6), lane = tid & 63, r32 = lane & 31, hi = lane >> 5;
    const int j_lo = swa_jlo(cur.P0, W);
    int j_hi = (cur.P0 + QB - 1) / KVBLK + 1; if (j_hi > skv / KVBLK) j_hi = skv / KVBLK;
    const int NT = j_hi - j_lo;
    const int kbn = swa_jlo(nxt.P0, W) * KVBLK;
    const int qlo = cur.P0 + wid * QBLK, qm = qlo + r32 - 4 * hi;
    char* V_lds = lds; char* K_lds = lds + 2 * SHM_V;
    float* ws = (float*)(lds + 2 * SHM_V + 2 * SHM_K) + wid * 64; float* li_l = ws, * al_l = ws + 32;
    float m_reg = -1e30f, l_reg = 0; f32x16 o[4] = {};
    const int sr = tid >> 4, sc = (tid & 15) * 8, vst0 = v_st(sr, sc), vst1 = v_st(32 + sr, sc), kws = KSWZ(sr, sc * 2);
    const int vb0 = (int)(uintptr_t)V_lds + v_rd_base(lane);
    const TIn* Kh = cur.K; const TIn* Vh = cur.V;
#define RESC(a) do { if (__any((a) < 1.f)) { if (hi == 0) al_l[r32] = (a); asm volatile("s_waitcnt lgkmcnt(0)" ::: "memory");              \
                     for (int d_ = 0; d_ < 4; ++d_) for (int r = 0; r < 16; ++r) o[d_][r] *= al_l[crow(r, hi)]; } } while (0)
#define KBASE(t) ((j_lo + (t)) * KVBLK)
#define BT(t) (bias_l + KBASE(t) + 4 * hi)
#define ACT(t) (KBASE(t) <= qlo + QBLK - 1 && KBASE(t) + KVBLK - 1 >= qlo - W + 1)
#define MASKT(P0_, P1_, t) do { const int kb_ = KBASE(t); if ((!SK || ACT(t)) && (kb_ + KVBLK - 1 > qlo || kb_ <= qlo + QBLK - 1 - W)) mask_tile(P0_, P1_, qm - kb_, (unsigned)W); } while (0)
    constexpr int NQL = F32 ? 16 : 8;
    constexpr bool SK = WSKIP && !F32;
#define SEAM_K0() do { VMWN(NQL); if constexpr (F32) { SWRITE_KF(0); SBAR(); SLOAD_F((const float*)nxt.V, kbn); } else { SWRITE_HK(0); } SBAR(); } while (0)
    f32x16 pA0, pA1, pB0, pB1; float mnA, mnB, alA, alB; bf16x8 pa0, pa1, pa2, pa3;
    if constexpr (F32) { VMW(); SWRITE_VF(0); SBAR(); } else { SWRITE_HV(0); SBAR(); }
    if (NT > 1) { if constexpr (F32) SLOAD_F((const float*)Kh, KBASE(1)); else SLOAD_H(Kh, Vh, KBASE(1)); }
    SBAR(); qkt<0, SK>(pA0, pA1, K_lds, r32, hi, S.qr, ACT(0), BT(0));
    if constexpr (F32) { if (NT > 1) { VMW(); SWRITE_KF(1); SBAR(); SLOAD_F((const float*)Vh, KBASE(1)); } }
    MASKT(pA0, pA1, 0); partialSM(pA0, pA1, m_reg, mnA, alA);
    if (NT > 1) { VMW(); if constexpr (F32) { SWRITE_VF(1); SBAR(); if (NT > 2) SLOAD_F((const float*)Kh, KBASE(2)); } else SWRITE_H(1); }
    __syncthreads();
#define HALF_STEP(PX0, PX1, mnX, alX, PY0, PY1, alY, t, KB, VB, SB) do {                                                      \
        SBAR(); qkt<KB, SK>(PX0, PX1, K_lds, r32, hi, S.qr, ACT(t), BT(t));                                             \
        finishSM(PY0, PY1, alY, l_reg, pa0, pa1, pa2, pa3); SBAR();                                                           \
        if ((t) + 1 < NT) { if constexpr (F32) { VMW(); SWRITE_KF(SB); SBAR(); SLOAD_F((const float*)Vh, KBASE((t) + 1)); }  \
                            else { SLOAD_H(Kh, Vh, KBASE((t) + 1)); } SBAR(); }                                               \
        pv_tile<VB, SK>(o, vb0, pa0, pa1, pa2, pa3, ACT((t) - 1)); MASKT(PX0, PX1, (t)); partialSM(PX0, PX1, m_reg, mnX, alX);                                        \
        __syncthreads();                                                                                                      \
        if ((t) + 1 < NT) { VMW(); if constexpr (F32) { SWRITE_VF(SB); SBAR(); if ((t) + 2 < NT) SLOAD_F((const float*)Kh, KBASE((t) + 2)); } \
                            else { SWRITE_H(SB); } }                                                                          \
        RESC(alX); __syncthreads(); } while (0)
    for (int t = 1; t + 1 < NT; t += 2) {
        HALF_STEP(pB0, pB1, mnB, alB, pA0, pA1, alA, t, 1, 0, 0);
        HALF_STEP(pA0, pA1, mnA, alA, pB0, pB1, alB, t + 1, 0, 1, 1);
    }
    const bool even = (NT & 1) == 0;
    if (even) { SBAR(); qkt<1, SK>(pB0, pB1, K_lds, r32, hi, S.qr, ACT(NT - 1), BT(NT - 1)); SBAR(); }
#define QROW(e) (nxt.Q + (size_t)(wid * QBLK + r32) * LDI + ((e) >> 1) * 16 + hi * 8 + ((e) & 1) * 4)
    if constexpr (F32) { SLOAD_F((const float*)nxt.K, kbn); SBAR();
#pragma unroll
        for (int e = 0; e < 8; ++e) S.tq[e] = *(const f32x4*)QROW(e); }
    else { SLOAD_H(nxt.K, nxt.V, kbn); SBAR();
#pragma unroll
        for (int d0 = 0; d0 < 8; ++d0) S.qr[d0] = load8<TIn>(nxt.Q + (size_t)(wid * QBLK + r32) * LDI + d0 * 16 + hi * 8); }
    SBAR();
    finishSM(pA0, pA1, alA, l_reg, pa0, pa1, pa2, pa3); SBAR();
    if constexpr (F32) {
#pragma unroll
        for (int e = 8; e < 16; ++e) S.tq[e] = *(const f32x4*)QROW(e); SBAR(); }
#undef QROW
    pv_tile<0, SK>(o, vb0, pa0, pa1, pa2, pa3, ACT(even ? NT - 2 : NT - 1));
    if (even) { MASKT(pB0, pB1, NT - 1); partialSM(pB0, pB1, m_reg, mnB, alB); __syncthreads(); RESC(alB);
        finishSM(pB0, pB1, alB, l_reg, pa0, pa1, pa2, pa3); SBAR(); pv_tile<1, SK>(o, vb0, pa0, pa1, pa2, pa3, ACT(NT - 1)); }
    SBAR(); SEAM_K0();
    if (hi == 0) li_l[r32] = l_reg; asm volatile("s_waitcnt lgkmcnt(0)" ::: "memory");
    float rli[16];
#pragma unroll
    for (int r = 0; r < 16; ++r) rli[r] = __builtin_amdgcn_rcpf(li_l[crow(r, hi)]);
    TOut* Ow = cur.O + (size_t)(wid * QBLK) * LDO;
#pragma unroll
    for (int r = 0; r < 16; ++r) { const int orow = crow(r, hi);
        float v4[4]; float ss = 0.f;
#pragma unroll
        for (int d0 = 0; d0 < 4; ++d0) { v4[d0] = o[d0][r] * rli[r]; ss += v4[d0] * v4[d0]; }
        ss += __shfl_xor(ss, 1); ss += __shfl_xor(ss, 2); ss += __shfl_xor(ss, 4); ss += __shfl_xor(ss, 8); ss += __shfl_xor(ss, 16);
        const float rn = __builtin_amdgcn_rsqf(ss * (1.f / 128.f) + 1e-6f);
#pragma unroll
        for (int d0 = 0; d0 < 4; ++d0) { const float v = v4[d0] * rn * onorm[d0 * 32 + r32];
            const float vn = __shfl_xor(v, 1);
            if ((r32 & 1) == 0) *(unsigned*)(Ow + (size_t)orow * LDO + d0 * 32 + r32) = cvtpk(v, vn); } }
    if constexpr (F32) {
#pragma unroll
        for (int d0 = 0; d0 < 8; ++d0) S.qr[d0] = pack8(S.tq[2 * d0], S.tq[2 * d0 + 1]); }
    __syncthreads();
#undef RESC
#undef KBASE
#undef BT
#undef ACT
#undef MASKT
#undef SEAM_K0
#undef HALF_STEP
}
#undef ROW
#undef VMW
}
__device__ __forceinline__ fa::BlockRef<bf16_t, bf16_t> fox_ref(int Li, int pass, const bf16_t* QKV, bf16_t* O) {
    using namespace fa;
    BlockRef<bf16_t, bf16_t> r; const int xcd = Li & 7, k = Li >> 3, bh = (k >> 4) * 8 + xcd, x = k & 15, qb = pass ? 31 - x : x, b = bh >> 3, h = bh & 7;
    r.Q = QKV + ((size_t)((0 * NB + b) * NHD + h) * SEQ + qb * QB) * 128; r.K = QKV + ((size_t)((1 * NB + b) * NHD + h) * SEQ) * 128; r.V = QKV + ((size_t)((2 * NB + b) * NHD + h) * SEQ) * 128;
    r.O = O + ((size_t)(b * SEQ + qb * QB)) * LDO + h * 128; r.P0 = qb * QB; return r;
}
__device__ __forceinline__ void phase_attn(const bf16_t* __restrict__ QKV, bf16_t* __restrict__ O, const float* __restrict__ BIAS, const float* __restrict__ onorm, char* lds) {
    using namespace fa;
    float* bias_l = (float*)(lds + LDS_BYTES);
    constexpr int total = 512;
    int L = blockIdx.x; if (L >= total) return;
    const int stride = gridDim.x, tid = opaque_tid();
    int pass = 0, loaded = -1; int Wr; asm volatile("s_mov_b32 %0, 8192" : "=s"(Wr));
    BlockRef<bf16_t, bf16_t> cur = fox_ref(L, 0, QKV, O);
    Seam<bf16_t> S;
    causal_swa_prime<bf16_t, bf16_t>(cur, Wr, lds, S);
    for (;;) {
        const bool more_pass = pass == 0, more_item = L + stride < total, last = !more_pass && !more_item;
        int passn = pass + 1, Ln = L;
        if (!more_pass) { passn = 0; Ln = more_item ? L + stride : L; }
        const BlockRef<bf16_t, bf16_t> nxt = last ? cur : fox_ref(Ln, passn, QKV, O);
        const int bh = ((L >> 3) >> 4) * 8 + (L & 7);
        if (bh != loaded) { const float* src = BIAS + (size_t)bh * SEQ + tid * 4;
            const int wq = __builtin_amdgcn_readfirstlane(tid >> 6);
#pragma unroll
            for (int i = 0; i < 4; ++i) __builtin_amdgcn_global_load_lds((const unsigned*)(src + i * 2048), (PG8_LAS unsigned*)(bias_l + i * 2048 + wq * 256), 16, 0, 0);
            asm volatile("s_waitcnt vmcnt(0)" ::: "memory");
            loaded = bh; __syncthreads(); }
        causal_swa_block<bf16_t, bf16_t>(cur, nxt, SEQ, Wr, lds, S, bias_l, onorm);
        if (last) break;
        cur = nxt; pass = passn; L = Ln;
    }
}

#ifndef PH_MASK
#define PH_MASK 0xFFFF
#endif
#define PH(b) if constexpr ((PH_MASK >> (b)) & 1)
#ifndef DUP_MASK
#define DUP_MASK 0
#endif
#define DUP(b) if constexpr ((DUP_MASK >> (b)) & 1)
__global__ void __launch_bounds__(512, 2) fwd_megakernel(Params p) {
    extern __shared__ __attribute__((aligned(16))) unsigned char shm[];
    cg::grid_group grid = cg::this_grid();
    PG8_LAS unsigned char* glds = (PG8_LAS unsigned char*)shm;
    float* tile = (float*)shm;
    pg8::StaticOrder S;
    DUP(0) { phase_prologue(p, shm); grid.sync(); }
    DUP(11) { float* cond = (float*)shm; for (int i = opaque_tid(); i < 8192; i += 512) { const float c = p.c[i]; cond[i] = c / (1.f + __expf(-c)); } __syncthreads(); for (int t = blockIdx.x; t < 288; t += gridDim.x) mod_task(p, t, cond, cond + 8192); grid.sync(); }
    DUP(12) { conv_run<0>(p, CT_GU + CT_D + CT_IN + CT_OUT, tile); grid.sync(); }
    PH(0) phase_prologue(p, shm);
    grid.sync();
    PH(1) phase_norm(p.x, p.norm_g, p.MOD_(), 0, 1, p.H_());
    PH(1) phase_cb(p.WIN_(), NPROJ, p.MOD_() + 3 * DM, p.CB1_());
    grid.sync();
    PH(2) { pg8::Gemm g{p.H_(), p.WGU_(), MTOK, 2 * DFF, DM}; S.init(g.M, g.N, (int)gridDim.x, (int)blockIdx.x); EpiSwiGLU<false> E{p};
      pg8::gemm_phase<EpiSwiGLU<false>, pg8::StaticOrder, false>(glds, g, S, E, nullptr); }
    grid.sync();
    PH(3) { pg8::Gemm g{p.HID_(), p.WD_(), MTOK, DM, DFF}; S.init(g.M, g.N, (int)gridDim.x, (int)blockIdx.x);
      EpiResid<0> E{p};
      pg8::gemm_phase<EpiResid<0>, pg8::StaticOrder, false>(glds, g, S, E, nullptr); }
    grid.sync();
    PH(4) { pg8::Gemm g{p.H_(), p.WIN_(), MTOK, NPROJ, DM}; S.init(g.M, g.N, (int)gridDim.x, (int)blockIdx.x); EpiProj E{p};
      pg8::gemm_phase<EpiProj, pg8::StaticOrder, false>(glds, g, S, E, nullptr); }
    grid.sync();
    DUP(5) { phase_g1(p, shm); grid.sync(); }
    PH(5) phase_g1(p, shm);
    grid.sync();
    DUP(6) { phase_g2(p, shm); grid.sync(); }
    DUP(7) { phase_attn(p.QKVF_(), p.H_(), p.BIAS_(), p.fox_out_norm, (char*)shm); grid.sync(); }
    PH(6) phase_g2(p, shm);
    PH(7) phase_attn(p.QKVF_(), p.H_(), p.BIAS_(), p.fox_out_norm, (char*)shm);
    grid.sync();
    PH(8) phase_gdn_out(p);
    PH(8) conv_run<1>(p, CT_GU + CT_D, tile);
    grid.sync();
    PH(9) { pg8::Gemm g{p.H_(), p.WOUT_(), MTOK, DM, DM}; S.init(g.M, g.N, (int)gridDim.x, (int)blockIdx.x);
      EpiResid<1> E{p};
      pg8::gemm_phase<EpiResid<1>, pg8::StaticOrder, false>(glds, g, S, E, nullptr); }
    PH(9) phase_cb(p.WGU_(), 2 * DFF, p.MOD_() + 6 * DM, p.CB2_());
    grid.sync();
    PH(2) { pg8::Gemm g{p.HB2_(), p.WGU_(), MTOK, 2 * DFF, DM}; S.init(g.M, g.N, (int)gridDim.x, (int)blockIdx.x); EpiSwiGLU<true> E{p};
      pg8::gemm_phase<EpiSwiGLU<true>, pg8::StaticOrder, false>(glds, g, S, E, nullptr); }
    grid.sync();
    PH(3) { pg8::Gemm g{p.HID_(), p.WD_(), MTOK, DM, DFF}; S.init(g.M, g.N, (int)gridDim.x, (int)blockIdx.x);
      EpiResid<2> E{p};
      pg8::gemm_phase<EpiResid<2>, pg8::StaticOrder, false>(glds, g, S, E, nullptr); }
    grid.sync();
    PH(10) phase_final_norm(p.out, p.final_norm);
}

extern "C" void kernel_launch(void* const* d_in, const int* in_sizes, int n_in, void* d_out, int out_size, void* d_ws, size_t ws_size, hipStream_t stream) {
    static int grid_blocks = 0;
    if (grid_blocks == 0) {
        if (n_in != 17 || out_size != MTOK * DM || ws_size < O_END) { fprintf(stderr, "kernel_launch: unexpected shapes (n_in %d out %d ws %zu need %zu)\n", n_in, out_size, ws_size, (size_t)O_END); grid_blocks = -1; return; }
        int dev = 0, cus = 0, per_cu = 0;
        hipGetDevice(&dev); hipDeviceGetAttribute(&cus, hipDeviceAttributeMultiprocessorCount, dev);
        if (hipFuncSetAttribute((const void*)fwd_megakernel, hipFuncAttributeMaxDynamicSharedMemorySize, LDS_TOTAL) != hipSuccess) { fprintf(stderr, "kernel_launch: hipFuncSetAttribute failed\n"); grid_blocks = -1; return; }
        if (hipOccupancyMaxActiveBlocksPerMultiprocessor(&per_cu, (const void*)fwd_megakernel, 512, LDS_TOTAL) != hipSuccess || per_cu < 1) { fprintf(stderr, "kernel_launch: occupancy query failed (%d)\n", per_cu); per_cu = 1; }
        (void)hipGetLastError();
        grid_blocks = cus * per_cu;
    }
    if (grid_blocks < 0) return;
    Params p{};
    const float** in = (const float**)&p;
    for (int i = 0; i < 17; ++i) in[i] = (const float*)d_in[i];
    unsigned char* ws = (unsigned char*)d_ws;
    p.out = (float*)d_out;
    p.ws = ws;
    void* args[] = {&p};
    hipError_t e = hipLaunchCooperativeKernel((const void*)fwd_megakernel, dim3(grid_blocks), dim3(512), args, LDS_TOTAL, stream);
    if (e != hipSuccess) fprintf(stderr, "cooperative launch failed: %s (grid %d)\n", hipGetErrorString(e), grid_blocks);
}
```
